# Optimizing an MI355X kernel written in HIP

```python
import math
import jax, jax.numpy as jnp
from jax import lax
import numpy as np

D_MODEL = 1024
BATCH = 8
SEQ = 8192
DEPTH = 4

HEAD_DIM = 64
N_HEADS_A = 8
ROT_DIM_A = HEAD_DIM // 4
DILATED_BRANCHES = ((128, 1), (512, 4), (2048, 16))
FNET_GROUPS = 4
FNET_GROUP_DIM = 64
N_HEADS_C = 8
C_NOPE_DIM = 64
C_ROPE_DIM = 32
C_V_DIM = 64
C_Q_RANK = 256
C_KV_RANK = 128
S5_GROUPS = 16
S5_GROUP_DIM = 16
S5_STATE = 64
S5_MIN_STEP = 1e-3
S5_MAX_STEP = 1e-1
D_FF = 2816
ROPE_THETA = 500000.0
Q_BLOCK = 128
NORM_EPS = 1e-6
NEG_INF = -1e30
MAX_POS_OFFSET = 1024

A_WIDTH = N_HEADS_A * HEAD_DIM
B_WIDTH = FNET_GROUPS * FNET_GROUP_DIM
EVEN_IN = 3 * A_WIDTH + B_WIDTH
EVEN_OUT = A_WIDTH + B_WIDTH
C_QK_DIM = C_NOPE_DIM + C_ROPE_DIM
C_WIDTH = N_HEADS_C * C_V_DIM
D_WIDTH = S5_GROUPS * S5_GROUP_DIM
ODD_IN = C_Q_RANK + C_KV_RANK + C_ROPE_DIM + D_WIDTH
ODD_OUT = C_WIDTH + D_WIDTH

kernel_name = 'hybrid_dilated_fnet_mla_s5_encoder'


def rms_norm(x, g):
    xf = x.astype(jnp.float32)
    y = xf * lax.rsqrt(jnp.mean(xf * xf, axis=-1, keepdims=True) + NORM_EPS)
    return (y * g.astype(jnp.float32)).astype(x.dtype)


def swiglu(h, w_gate, w_up, w_down):
    return (jax.nn.silu(h @ w_gate) * (h @ w_up)) @ w_down


def rotary_tables(positions, rot_dim):
    inv_freq = ROPE_THETA ** (-jnp.arange(0, rot_dim, 2, dtype=jnp.float32) / rot_dim)
    ang = positions.astype(jnp.float32)[..., None] * inv_freq
    ang = jnp.concatenate([ang, ang], axis=-1)
    return jnp.cos(ang)[:, :, None, :], jnp.sin(ang)[:, :, None, :]


def apply_rotary(t, cos, sin):
    tf = t.astype(jnp.float32)
    half = t.shape[-1] // 2
    rot = jnp.concatenate([-tf[..., half:], tf[..., :half]], axis=-1)
    return (tf * cos + rot * sin).astype(t.dtype)


def dilated_window_branch(q, k, v, dilation, radius):
    bsz, s_len, n_h, e = q.shape
    L = s_len // dilation
    nb = -(-L // radius)
    lp = nb * radius
    pad = lp - L

    def to_sub(t):
        return t.reshape(bsz, L, dilation, n_h, e).transpose(0, 2, 1, 3, 4)

    qs = jnp.pad(to_sub(q), ((0, 0), (0, 0), (0, pad), (0, 0), (0, 0)))
    qs = qs.reshape(bsz, dilation, nb, radius, n_h, e)

    def neighbourhood(t):
        t = jnp.pad(to_sub(t), ((0, 0), (0, 0), (radius, pad + radius), (0, 0), (0, 0)))
        t = t.reshape(bsz, dilation, nb + 2, radius, n_h, e)
        return jnp.concatenate([t[:, :, :-2], t[:, :, 1:-1], t[:, :, 2:]], axis=3)

    kn = neighbourhood(k).astype(jnp.float32)
    vn = neighbourhood(v).astype(jnp.float32)
    s = jnp.einsum('bdnqhe,bdnkhe->bdnhqk', qs.astype(jnp.float32), kn) * (e ** -0.5)
    qi = jnp.arange(radius)
    ki = jnp.arange(3 * radius)
    band = jnp.abs(ki[None, :] - radius - qi[:, None]) <= radius
    key_pos = (jnp.arange(nb)[:, None] - 1) * radius + ki[None, :]
    valid = (key_pos >= 0) & (key_pos < L)
    mask = band[None, :, :] & valid[:, None, :]
    s = jnp.where(mask[:, None, :, :], s, NEG_INF)
    lse = jax.nn.logsumexp(s, axis=-1)
    p = jnp.exp(s - lse[..., None])
    o = jnp.einsum('bdnhqk,bdnkhe->bdnqhe', p, vn)
    o = o.reshape(bsz, dilation, lp, n_h, e)[:, :, :L]
    o = o.transpose(0, 2, 1, 3, 4).reshape(bsz, s_len, n_h, e)
    lse = lse.transpose(0, 1, 2, 4, 3).reshape(bsz, dilation, lp, n_h)[:, :, :L]
    lse = lse.transpose(0, 2, 1, 3).reshape(bsz, s_len, n_h)
    return o, lse


def dense_attention_blocks(q, k, v):
    bsz, s_len, n_h, e = q.shape
    ev = v.shape[-1]
    nq = s_len // Q_BLOCK
    qb = q.reshape(bsz, nq, Q_BLOCK, n_h, e).transpose(1, 0, 2, 3, 4)
    kf = k.astype(jnp.float32)
    vf = v.astype(jnp.float32)
    scale = e ** -0.5

    def one_block(q_blk):
        s = jnp.einsum('bqhe,bkhe->bhqk', q_blk.astype(jnp.float32), kf) * scale
        p = jax.nn.softmax(s, axis=-1)
        return jnp.einsum('bhqk,bkhv->bqhv', p, vf)

    o = lax.map(one_block, qb)
    return o.transpose(1, 0, 2, 3, 4).reshape(bsz, s_len, n_h, ev).astype(q.dtype)


def even_mixer(h, cos_a, sin_a, w_in, w_out, q_norm, k_norm, b_mix):
    bsz, s_len, _ = h.shape
    z = h @ w_in
    q, k, v, f = jnp.split(z, [A_WIDTH, 2 * A_WIDTH, 3 * A_WIDTH], axis=-1)
    q = rms_norm(q.reshape(bsz, s_len, N_HEADS_A, HEAD_DIM), q_norm)
    k = rms_norm(k.reshape(bsz, s_len, N_HEADS_A, HEAD_DIM), k_norm)
    v = v.reshape(bsz, s_len, N_HEADS_A, HEAD_DIM)
    q = jnp.concatenate([apply_rotary(q[..., :ROT_DIM_A], cos_a, sin_a), q[..., ROT_DIM_A:]], axis=-1)
    k = jnp.concatenate([apply_rotary(k[..., :ROT_DIM_A], cos_a, sin_a), k[..., ROT_DIM_A:]], axis=-1)
    outs, lses = [], []
    for window, dilation in DILATED_BRANCHES:
        o, lse = dilated_window_branch(q, k, v, dilation, window // (2 * dilation))
        outs.append(o)
        lses.append(lse)
    wts = jax.nn.softmax(jnp.stack(lses, axis=0), axis=0)
    a_out = jnp.sum(wts[..., None] * jnp.stack(outs, axis=0), axis=0).reshape(bsz, s_len, A_WIDTH)
    fg = f.astype(jnp.float32).reshape(bsz, s_len, FNET_GROUPS, FNET_GROUP_DIM).transpose(0, 2, 1, 3)
    spec = jnp.fft.fft2(fg, norm='ortho').real
    b_out = jnp.einsum('bgsc,gcd->bsgd', spec, b_mix.astype(jnp.float32)).reshape(bsz, s_len, B_WIDTH)
    merged = jnp.concatenate([a_out, b_out], axis=-1).astype(h.dtype)
    return merged @ w_out


def _linear_recurrence(left, right):
    a_l, b_l = left
    a_r, b_r = right
    return a_l * a_r, a_r * b_l + b_r


def s5_bidirectional(u, lam_re, lam_im, log_step, b_re, b_im, c_re, c_im, d_skip, w_glu, b_glu):
    bsz, s_len, _ = u.shape
    uf = u.astype(jnp.float32)
    ug = uf.reshape(bsz, s_len, S5_GROUPS, S5_GROUP_DIM)
    lam = lax.complex(lam_re.astype(jnp.float32), lam_im.astype(jnp.float32))
    step = jnp.exp(log_step.astype(jnp.float32))[..., None]
    lam_bar = jnp.exp(lam * step)
    b_bar = ((lam_bar - 1.0) / lam)[..., None] * lax.complex(b_re.astype(jnp.float32), b_im.astype(jnp.float32))
    c_mat = lax.complex(c_re.astype(jnp.float32), c_im.astype(jnp.float32))
    y = uf * d_skip.astype(jnp.float32)
    for direction, reverse in ((0, False), (1, True)):
        bu = jnp.einsum('bsgh,gph->bsgp', ug, b_bar[direction])
        a = jnp.broadcast_to(lam_bar[direction][None, None], (1, s_len, S5_GROUPS, S5_STATE))
        _, states = lax.associative_scan(_linear_recurrence, (a, bu), reverse=reverse, axis=1)
        y = y + jnp.einsum('bsgp,ghp->bsgh', states, c_mat[direction]).real.reshape(bsz, s_len, D_WIDTH)
    z = jax.nn.gelu(y)
    out = z * jax.nn.sigmoid(z @ w_glu.astype(jnp.float32) + b_glu.astype(jnp.float32))
    return out.astype(u.dtype)


def odd_mixer(h, cos_c, sin_c, w_in, w_out, q_lat_norm, w_q_up, kv_lat_norm, w_kv_up, q_norm, k_norm,
              lam_re, lam_im, log_step, b_re, b_im, c_re, c_im, d_skip, w_glu, b_glu):
    bsz, s_len, _ = h.shape
    z = h @ w_in
    q_lat, kv_lat, k_pe, u = jnp.split(z, [C_Q_RANK, C_Q_RANK + C_KV_RANK, C_Q_RANK + C_KV_RANK + C_ROPE_DIM], axis=-1)
    q = (rms_norm(q_lat, q_lat_norm) @ w_q_up).reshape(bsz, s_len, N_HEADS_C, C_QK_DIM)
    kv = (rms_norm(kv_lat, kv_lat_norm) @ w_kv_up).reshape(bsz, s_len, N_HEADS_C, C_NOPE_DIM + C_V_DIM)
    k_nope, v = kv[..., :C_NOPE_DIM], kv[..., C_NOPE_DIM:]
    k_pe = jnp.broadcast_to(k_pe[:, :, None, :], (bsz, s_len, N_HEADS_C, C_ROPE_DIM))
    k = jnp.concatenate([k_nope, k_pe], axis=-1)
    q = rms_norm(q, q_norm)
    k = rms_norm(k, k_norm)
    q = jnp.concatenate([q[..., :C_NOPE_DIM], apply_rotary(q[..., C_NOPE_DIM:], cos_c, sin_c)], axis=-1)
    k = jnp.concatenate([k[..., :C_NOPE_DIM], apply_rotary(k[..., C_NOPE_DIM:], cos_c, sin_c)], axis=-1)
    c_out = dense_attention_blocks(q, k, v).reshape(bsz, s_len, C_WIDTH)
    d_out = s5_bidirectional(u, lam_re, lam_im, log_step, b_re, b_im, c_re, c_im, d_skip, w_glu, b_glu)
    merged = jnp.concatenate([c_out, d_out.astype(c_out.dtype)], axis=-1).astype(h.dtype)
    return merged @ w_out


def setup_inputs(seed: int = 0) -> dict:
    key = jax.random.key(seed)
    ks = iter(jax.random.split(key, 40))
    f32 = jnp.float32

    def normal(shape, scale):
        return jax.random.normal(next(ks), shape, f32) * scale

    def gain(shape):
        return 1.0 + normal(shape, 0.02)

    ne, no = (DEPTH + 1) // 2, DEPTH // 2
    x = normal((BATCH, SEQ, D_MODEL), 1.0)
    start = jax.random.randint(next(ks), (BATCH, 1), 0, MAX_POS_OFFSET, dtype=jnp.int32)
    positions = start + jnp.arange(SEQ, dtype=jnp.int32)[None, :]
    d_in, f_in = D_MODEL ** -0.5, D_FF ** -0.5
    return {
        'x': x,
        'positions': positions,
        'ffn1_norm': gain((DEPTH, D_MODEL)),
        'ffn1_w_gate': normal((DEPTH, D_MODEL, D_FF), d_in),
        'ffn1_w_up': normal((DEPTH, D_MODEL, D_FF), d_in),
        'ffn1_w_down': normal((DEPTH, D_FF, D_MODEL), f_in),
        'mix_norm': gain((DEPTH, D_MODEL)),
        'ffn2_norm': gain((DEPTH, D_MODEL)),
        'ffn2_w_gate': normal((DEPTH, D_MODEL, D_FF), d_in),
        'ffn2_w_up': normal((DEPTH, D_MODEL, D_FF), d_in),
        'ffn2_w_down': normal((DEPTH, D_FF, D_MODEL), f_in),
        'ab_w_in': normal((ne, D_MODEL, EVEN_IN), d_in),
        'ab_w_out': normal((ne, EVEN_OUT, D_MODEL), EVEN_OUT ** -0.5),
        'a_q_norm': gain((ne, HEAD_DIM)),
        'a_k_norm': gain((ne, HEAD_DIM)),
        'b_w_mix': normal((ne, FNET_GROUPS, FNET_GROUP_DIM, FNET_GROUP_DIM), FNET_GROUP_DIM ** -0.5),
        'cd_w_in': normal((no, D_MODEL, ODD_IN), d_in),
        'cd_w_out': normal((no, ODD_OUT, D_MODEL), ODD_OUT ** -0.5),
        'c_q_lat_norm': gain((no, C_Q_RANK)),
        'c_w_q_up': normal((no, C_Q_RANK, N_HEADS_C * C_QK_DIM), C_Q_RANK ** -0.5),
        'c_kv_lat_norm': gain((no, C_KV_RANK)),
        'c_w_kv_up': normal((no, C_KV_RANK, N_HEADS_C * (C_NOPE_DIM + C_V_DIM)), C_KV_RANK ** -0.5),
        'c_q_norm': gain((no, C_QK_DIM)),
        'c_k_norm': gain((no, C_QK_DIM)),
        'd_lam_re': -0.5 + normal((no, 2, S5_GROUPS, S5_STATE), 0.01),
        'd_lam_im': jnp.pi * jnp.arange(S5_STATE, dtype=f32) + normal((no, 2, S5_GROUPS, S5_STATE), 0.01),
        'd_log_step': jax.random.uniform(next(ks), (no, 2, S5_GROUPS), f32, math.log(S5_MIN_STEP), math.log(S5_MAX_STEP)),
        'd_b_re': normal((no, 2, S5_GROUPS, S5_STATE, S5_GROUP_DIM), (2 * S5_GROUP_DIM) ** -0.5),
        'd_b_im': normal((no, 2, S5_GROUPS, S5_STATE, S5_GROUP_DIM), (2 * S5_GROUP_DIM) ** -0.5),
        'd_c_re': normal((no, 2, S5_GROUPS, S5_GROUP_DIM, S5_STATE), (2 * S5_STATE) ** -0.5),
        'd_c_im': normal((no, 2, S5_GROUPS, S5_GROUP_DIM, S5_STATE), (2 * S5_STATE) ** -0.5),
        'd_skip': normal((no, D_WIDTH), 1.0),
        'd_w_glu': normal((no, D_WIDTH, D_WIDTH), D_WIDTH ** -0.5),
        'd_b_glu': normal((no, D_WIDTH), 0.01),
    }


def reference(x, positions, ffn1_norm, ffn1_w_gate, ffn1_w_up, ffn1_w_down, mix_norm,
              ffn2_norm, ffn2_w_gate, ffn2_w_up, ffn2_w_down,
              ab_w_in, ab_w_out, a_q_norm, a_k_norm, b_w_mix,
              cd_w_in, cd_w_out, c_q_lat_norm, c_w_q_up, c_kv_lat_norm, c_w_kv_up, c_q_norm, c_k_norm,
              d_lam_re, d_lam_im, d_log_step, d_b_re, d_b_im, d_c_re, d_c_im, d_skip, d_w_glu, d_b_glu):
    cos_a, sin_a = rotary_tables(positions, ROT_DIM_A)
    cos_c, sin_c = rotary_tables(positions, C_ROPE_DIM)
    for layer in range(DEPTH):
        x = x + 0.5 * swiglu(rms_norm(x, ffn1_norm[layer]), ffn1_w_gate[layer], ffn1_w_up[layer], ffn1_w_down[layer])
        h = rms_norm(x, mix_norm[layer])
        i = layer // 2
        if layer % 2 == 0:
            x = x + even_mixer(h, cos_a, sin_a, ab_w_in[i], ab_w_out[i], a_q_norm[i], a_k_norm[i], b_w_mix[i])
        else:
            x = x + odd_mixer(h, cos_c, sin_c, cd_w_in[i], cd_w_out[i], c_q_lat_norm[i], c_w_q_up[i],
                              c_kv_lat_norm[i], c_w_kv_up[i], c_q_norm[i], c_k_norm[i],
                              d_lam_re[i], d_lam_im[i], d_log_step[i], d_b_re[i], d_b_im[i],
                              d_c_re[i], d_c_im[i], d_skip[i], d_w_glu[i], d_b_glu[i])
        x = x + 0.5 * swiglu(rms_norm(x, ffn2_norm[layer]), ffn2_w_gate[layer], ffn2_w_up[layer], ffn2_w_down[layer])
    return x
```

```cpp
#include <hip/hip_runtime.h>
#include <hip/hip_cooperative_groups.h>
#include <cstdint>
#include <cstdio>
namespace cg = cooperative_groups;

#define DI __device__ __forceinline__
#define LAS __attribute__((address_space(3)))
typedef unsigned short bf16_t;
typedef short bf16x8 __attribute__((ext_vector_type(8)));
typedef short s16x4 __attribute__((ext_vector_type(4)));
typedef float f32x2 __attribute__((ext_vector_type(2)));
typedef float f32x4 __attribute__((ext_vector_type(4)));
typedef float f32x16 __attribute__((ext_vector_type(16)));
typedef unsigned u32x2 __attribute__((ext_vector_type(2)));
typedef unsigned u32x4 __attribute__((ext_vector_type(4)));

constexpr int NB = 8, SEQ = 8192, T = NB * SEQ, DM = 1024, FF = 2816, DEPTH = 4;
constexpr float EPS = 1e-6f;
constexpr float LOG2E = 1.4426950408889634f;

constexpr size_t MiB = 1u << 20;
constexpr size_t WS_WFFN = 1 * MiB;
constexpr size_t WFFN_STRIDE = 16 * MiB + MiB / 2;
constexpr size_t WS_WEVEN = WS_WFFN + 8 * WFFN_STRIDE;
constexpr size_t WEVEN_STRIDE = 5 * MiB;
constexpr size_t WS_WODD = WS_WEVEN + 2 * WEVEN_STRIDE;
constexpr size_t WODD_STRIDE = 52 * MiB;
constexpr size_t WO_IN = 0, WO_Q = 1 * MiB + MiB / 2, WO_KV = 2 * MiB, WO_OUT = 2 * MiB + MiB / 2, WO_GLU = 4 * MiB, WO_EMAT = 4 * MiB + MiB / 2  , WO_TMAT = 12 * MiB + MiB / 2  ;
constexpr size_t WODD_STRIDE2 = 53 * MiB;
constexpr size_t WS_FCONST = WS_WODD + 2 * WODD_STRIDE2;
constexpr size_t FC_D128C = 0, FC_D128NS = 32768, FC_D64C = 65536, FC_D64S = 65536 + 8192, FC_D64NS = 65536 + 16384, FC_TW = 131072  , FC_PT = 262144  , FC_QT = 262144 + 65536;
constexpr size_t WS_S5TAB = WS_FCONST + 1 * MiB;
constexpr size_t S5_KTAB = 0, S5_LP = 4 * MiB, S5_BB = 7 * MiB;
constexpr size_t WS_ROPEA = WS_S5TAB + 8 * MiB;
constexpr size_t WS_ROPEC = WS_ROPEA + 4 * MiB;
constexpr size_t WS_XB = WS_ROPEC + 8 * MiB;
constexpr size_t WS_SSQ = WS_XB + 128 * MiB;
constexpr size_t WS_HID = WS_SSQ + 4 * MiB;
constexpr size_t WS_MERGED = WS_HID + 352 * MiB;
constexpr size_t WS_MIX2 = WS_MERGED + 96 * MiB;
constexpr size_t WS_END = WS_MIX2 + 92 * MiB;
constexpr size_t EV_Q = 0, EV_K = 64 * MiB, EV_V = 128 * MiB, EV_F = 192 * MiB, EV_YP = 224 * MiB;
constexpr size_t OD_QLAT = 0, OD_KVLAT = 32 * MiB, OD_KPE = 48 * MiB, OD_SSQQ = 56 * MiB, OD_SSQKV = 57 * MiB, OD_SSPE = 58 * MiB, OD_QH = 60 * MiB, OD_KH = 156 * MiB, OD_VH = 252 * MiB;
constexpr size_t M2_UA = 0  , M2_EB = 40 * MiB  , M2_Z = 56 * MiB  , M2_LSE = 88 * MiB  ;

constexpr int LDS_BYTES = 147456;
#ifndef RMASK
#define RMASK 0xFFFFF
#endif
#ifndef MULTI
#define MULTI 0
#endif
#ifndef NOSTORE
#define NOSTORE 0
#endif
#ifndef LDSCLEAR
#define LDSCLEAR 0
#endif
#ifndef ZMODE
#define ZMODE 0
#endif
#ifndef NLAYERS
#define NLAYERS DEPTH
#endif
#ifndef PM
#define PM 0xFFFFF
#endif

DI const float* INP(int k) { auto p = __builtin_amdgcn_kernarg_segment_ptr(); asm volatile("" : "+s"(p));
    typedef const float* cfp; return ((__attribute__((address_space(4))) const cfp*)p)[k]; }
DI int lane_id() { int l; asm volatile("v_mbcnt_lo_u32_b32 %0, -1, 0\n\tv_mbcnt_hi_u32_b32 %0, -1, %0" : "=v"(l)); return l; }
DI float shx(float v, int mask) { const int l = lane_id(); return __int_as_float(__builtin_amdgcn_ds_bpermute((l ^ mask) << 2, __float_as_int(v))); }
#define GET_TID(wv) int tid_ = (wv) * 64 + lane_id(); asm volatile("" : "+v"(tid_))
#ifdef USE_CG_SYNC
DI void gbar(unsigned* ctr, unsigned& epoch, int wv) {
    asm volatile("s_waitcnt vmcnt(0) lgkmcnt(0)" ::: "memory");
    __builtin_amdgcn_fence(__ATOMIC_RELEASE, "agent");
    asm volatile("s_waitcnt vmcnt(0)" ::: "memory");
    cg::this_grid().sync();
    __builtin_amdgcn_fence(__ATOMIC_ACQUIRE, "agent");
    asm volatile("s_waitcnt vmcnt(0)" ::: "memory");
    __syncthreads(); }
#else
DI void gbar(unsigned* ctr, unsigned& epoch, int wv) {
    asm volatile("s_waitcnt vmcnt(0) lgkmcnt(0)" ::: "memory");
    __syncthreads();
    ++epoch;
    unsigned target = epoch * gridDim.x; asm volatile("" : "+s"(target));
    if (wv == 0 && lane_id() == 0) {
        __builtin_amdgcn_fence(__ATOMIC_RELEASE, "agent");
        asm volatile("s_waitcnt vmcnt(0)" ::: "memory");
        __hip_atomic_fetch_add(ctr, 1u, __ATOMIC_RELAXED, __HIP_MEMORY_SCOPE_AGENT);
        while (__hip_atomic_load(ctr, __ATOMIC_RELAXED, __HIP_MEMORY_SCOPE_AGENT) < target) __builtin_amdgcn_s_sleep(2);
        __builtin_amdgcn_fence(__ATOMIC_ACQUIRE, "agent");
        asm volatile("s_waitcnt vmcnt(0)" ::: "memory");
    }
    __syncthreads();
}
#endif
DI void gbar_grp(unsigned* ctr0, unsigned& gepoch, int wv) {
    asm volatile("s_waitcnt vmcnt(0) lgkmcnt(0)" ::: "memory");
    __syncthreads();
    ++gepoch;
    unsigned target = gepoch * (gridDim.x >> 3); asm volatile("" : "+s"(target));
    if (wv == 0 && lane_id() == 0) {
        unsigned* ctr = ctr0 + 64 * (blockIdx.x & 7);
        __builtin_amdgcn_fence(__ATOMIC_RELEASE, "agent");
        asm volatile("s_waitcnt vmcnt(0)" ::: "memory");
        __hip_atomic_fetch_add(ctr, 1u, __ATOMIC_RELAXED, __HIP_MEMORY_SCOPE_AGENT);
        while (__hip_atomic_load(ctr, __ATOMIC_RELAXED, __HIP_MEMORY_SCOPE_AGENT) < target) __builtin_amdgcn_s_sleep(2);
        __builtin_amdgcn_fence(__ATOMIC_ACQUIRE, "agent");
        asm volatile("s_waitcnt vmcnt(0)" ::: "memory");
    }
    __syncthreads();
}
DI unsigned cvtpk(float lo, float hi) { typedef __bf16 b2 __attribute__((ext_vector_type(2))); f32x2 v = {lo, hi}; b2 b = __builtin_convertvector(v, b2); return __builtin_bit_cast(unsigned, b); }
DI float bf2f(unsigned v) { return __uint_as_float(v << 16); }
DI float bflo(unsigned v) { return __uint_as_float(v << 16); }
DI float bfhi(unsigned v) { return __uint_as_float(v & 0xffff0000u); }
DI int crow(int reg, int h) { return (reg & 3) + 8 * (reg >> 2) + 4 * h; }
#define MFMA32(a, b, c) __builtin_amdgcn_mfma_f32_32x32x16_bf16((a), (b), (c), 0, 0, 0)
typedef short v4i16_t __attribute__((ext_vector_type(4)));
DI s16x4 trread(LAS const char* p) { return __builtin_bit_cast(s16x4, __builtin_amdgcn_ds_read_tr16_b64_v4i16((LAS v4i16_t*)p)); }
DI bf16x8 cat8(s16x4 lo, s16x4 hi) { return __builtin_shufflevector(lo, hi, 0, 1, 2, 3, 4, 5, 6, 7); }
DI bf16x8 pack8(const f32x16& x, int s) {
    u32x4 p; p.x = cvtpk(x[8 * s], x[8 * s + 1]); p.y = cvtpk(x[8 * s + 2], x[8 * s + 3]); p.z = cvtpk(x[8 * s + 4], x[8 * s + 5]); p.w = cvtpk(x[8 * s + 6], x[8 * s + 7]);
    return __builtin_bit_cast(bf16x8, p);
}
DI f32x16 zero16() { f32x16 z; for (int i = 0; i < 16; ++i) z[i] = 0.f; return z; }
DI f32x16 zero16p() { f32x16 z; for (int i = 0; i < 16; ++i) z[i] = 0.f; asm volatile("" : "+v"(z)); return z; }

namespace pg8 {
constexpr int BM = 256, BK = 64, HALF = 128, HTB = HALF * BK * 2, STAGE_BYTES = 8 * HTB, NXCD = 8, WGM = 8;
__host__ __device__ __forceinline__ int lds_byte(int r, int c) { const int st = (r >> 4) * 2 + (c >> 5), rr = r & 15, cc = c & 31, ob = rr * 64 + cc * 2; return st * 1024 + (ob ^ (((ob >> 9) & 1) << 5)); }
__host__ __device__ __forceinline__ void stage_rc(int b, int& R, int& C) { const int st = b / 1024, sb = b % 1024, swz = sb ^ (((sb >> 9) & 1) << 5); R = (st >> 1) * 16 + swz / 64; C = (st & 1) * 32 + (swz % 64) / 2; }
__host__ __device__ __forceinline__ int perm32(int rho) { const int n = rho >> 4, i = rho & 15; return 8 * (i >> 2) + 4 * n + (i & 3); }
struct Unit { int pm, pn; };
struct Gemm { const bf16_t* A; const bf16_t* Bt; int lda, ldb, K; };
struct StaticOrder {
    int nM, nN, nwg, G, c;
    __device__ void init(int M, int N, int G_, int c_) { nM = M / BM; nN = N / BM; nwg = nM * nN; G = G_; c = c_; }
    __device__ bool next(int i, Unit& u) const {
        const long L = (long)i * G + c; if (L >= nwg) return false;
        int wgid = (int)L; { const int q = nwg / NXCD, r = nwg % NXCD, xcd = wgid % NXCD, off = wgid / NXCD; wgid = (xcd < r ? xcd * (q + 1) : r * (q + 1) + (xcd - r) * q) + off; }
        const int nig = WGM * nN, gid = wgid / nig, fm = gid * WGM, gsz = (nM - fm) < WGM ? (nM - fm) : WGM;
        u.pm = fm + ((wgid % nig) % gsz); u.pn = (wgid % nig) / gsz; return true;
    }
};
struct GroupOrder {
    int ng, nm, nn, pms, pns, G, c;
    __device__ bool next(int i, Unit& u) const {
        const long L = (long)i * G + c; const int tot = ng * nm * nn; if (L >= tot) return false;
        const int id = (int)L, g = id / (nm * nn), r = id % (nm * nn); u.pm = g * pms + r % nm; u.pn = g * pns + r / nm; return true;
    }
};

template <class Epi, class Sched>
__device__ __forceinline__ void gemm_phase(LAS unsigned char* lds, const Gemm g, const Sched& S, const Epi& E, const int wid_in) {
    int wid = wid_in; asm volatile("" : "+s"(wid));
    const int wr = wid >> 2, wc = wid & 3;
    if (LDSCLEAR) { GET_TID(wid); const u32x4 z4 = {0u, 0u, 0u, 0u};
        for (int o = tid_ * 16; o < STAGE_BYTES; o += 8192) *(LAS u32x4*)(lds + o) = z4;
        asm volatile("s_waitcnt lgkmcnt(0)" ::: "memory"); __syncthreads(); }
    const int K = g.K, nt = K / BK;
    const char* gA = (const char*)g.A; const char* gB = (const char*)g.Bt;
    asm volatile("" : "+s"(gA), "+s"(gB));
    unsigned voffA[2], voffB[2]; int aoff, boff;
#define PG8_IDS() do { GET_TID(wid); const int l_ = tid_ & 63; \
        _Pragma("unroll") for (int i = 0; i < 2; ++i) { int R, C; stage_rc(tid_ * 16 + i * 8192, R, C); const int Rb = (R & ~31) + perm32(R & 31); \
            voffA[i] = (unsigned)(R * g.lda + C) * 2u; voffB[i] = (unsigned)(Rb * g.ldb + C) * 2u; } \
        aoff = lds_byte(wr * 64 + (l_ & 15), (l_ >> 4) * 8); boff = lds_byte(wc * 32 + (l_ & 15), (l_ >> 4) * 8); } while (0)
    PG8_IDS();
    const size_t kstep = (size_t)(BK * 2);
    const size_t hstepA = (size_t)HALF * g.lda * 2, hstepB = (size_t)HALF * g.ldb * 2;
    const size_t tstepA = 2 * hstepA, tstepB = 2 * hstepB;
    const unsigned ldsw = (unsigned)wid * 1024u;
#define PG8_SA(b, h) (((b) * 2 + (h)) * HTB)
#define PG8_SB(b, h) ((4 + (b) * 2 + (h)) * HTB)
#define PG8_STAGE(bufoff, gbase, voff) do { _Pragma("unroll") for (int _i = 0; _i < 2; ++_i) \
        __builtin_amdgcn_global_load_lds((const unsigned*)((const char*)(gbase) + (voff)[_i]), (LAS unsigned*)(lds + (bufoff) + ldsw + _i * 8192), 16, 0, 0); } while (0)
#define PG8_LDA(dst, b, h) do { _Pragma("unroll") for (int m = 0; m < 4; ++m) _Pragma("unroll") for (int k = 0; k < 2; ++k) dst[m][k] = *(const LAS bf16x8*)(lds + PG8_SA(b, h) + aoff + m * 2048 + k * 1024); } while (0)
#define PG8_LDB(dst, b, h) do { _Pragma("unroll") for (int n = 0; n < 2; ++n) _Pragma("unroll") for (int k = 0; k < 2; ++k) dst[n][k] = *(const LAS bf16x8*)(lds + PG8_SB(b, h) + boff + n * 2048 + k * 1024); } while (0)
#define PG8_MMA(ai, bj, At, Bt) do { __builtin_amdgcn_s_setprio(1); _Pragma("unroll") for (int m = 0; m < 4; ++m) _Pragma("unroll") for (int n = 0; n < 2; ++n) _Pragma("unroll") for (int k = 0; k < 2; ++k) \
        acc[ai][bj][m][n] = __builtin_amdgcn_mfma_f32_16x16x32_bf16(Bt[n][k], At[m][k], acc[ai][bj][m][n], 0, 0, 0); __builtin_amdgcn_s_setprio(0); } while (0)
#define PG8_WAIT_V(n) asm volatile("s_waitcnt vmcnt(" #n ")" ::: "memory")
#define PG8_WAIT_L(n) asm volatile("s_waitcnt lgkmcnt(" #n ")" ::: "memory")
#define PG8_BAR __builtin_amdgcn_s_barrier()
#define PG8_SCHED __builtin_amdgcn_sched_barrier(0)
    Unit cur, nxt; int ui = 0;
    if (!S.next(0, cur)) return;
    f32x4 acc[2][2][4][2];
#pragma unroll
    for (int a = 0; a < 2; ++a)
#pragma unroll
        for (int b = 0; b < 2; ++b)
#pragma unroll
            for (int m = 0; m < 4; ++m)
#pragma unroll
                for (int n = 0; n < 2; ++n) acc[a][b][m][n] = (f32x4){0.f, 0.f, 0.f, 0.f};
    bf16x8 At[4][2], B0[2][2], B1[2][2];
    const char* cA = gA + (size_t)cur.pm * tstepA; const char* cB = gB + (size_t)cur.pn * tstepB;
    PG8_STAGE(PG8_SB(0, 0), cB, voffB); PG8_STAGE(PG8_SB(0, 1), cB + hstepB, voffB); PG8_STAGE(PG8_SA(0, 0), cA, voffA); PG8_STAGE(PG8_SA(0, 1), cA + hstepA, voffA);
    if (wr == 1) PG8_BAR;
    PG8_WAIT_V(2); PG8_BAR;
    PG8_STAGE(PG8_SB(1, 0), cB + kstep, voffB); PG8_STAGE(PG8_SA(1, 0), cA + kstep, voffA); PG8_STAGE(PG8_SB(1, 1), cB + hstepB + kstep, voffB);
    PG8_WAIT_V(6); PG8_BAR;
    for (;;) {
        const bool has_next = S.next(ui + 1, nxt);
        const char* nA = has_next ? gA + (size_t)nxt.pm * tstepA : cA; const char* nB = has_next ? gB + (size_t)nxt.pn * tstepB : cB;
        for (int t = 0; t < nt; t += 2) {
            const bool last = (t == nt - 2);
            const char* a1 = cA + (size_t)(t + 1) * kstep;
            const char* a2 = last ? nA : cA + (size_t)(t + 2) * kstep; const char* b2 = last ? nB : cB + (size_t)(t + 2) * kstep;
            const char* a3 = a2 + kstep; const char* b3 = b2 + kstep;
            PG8_LDB(B0, 0, 0); PG8_LDB(B1, 0, 1); PG8_SCHED; PG8_LDA(At, 0, 0); PG8_STAGE(PG8_SA(1, 1), a1 + hstepA, voffA);
            PG8_WAIT_V(8); PG8_WAIT_L(0); PG8_BAR; PG8_MMA(0, 0, At, B0); PG8_MMA(0, 1, At, B1); PG8_BAR; PG8_SCHED;
            PG8_LDA(At, 0, 1); PG8_STAGE(PG8_SB(0, 0), b2, voffB); PG8_STAGE(PG8_SB(0, 1), b2 + hstepB, voffB); PG8_STAGE(PG8_SA(0, 0), a2, voffA);
            PG8_WAIT_V(8); PG8_WAIT_L(0); PG8_BAR; PG8_MMA(1, 0, At, B0); PG8_MMA(1, 1, At, B1); PG8_BAR; PG8_SCHED;
            PG8_LDB(B0, 1, 0); PG8_LDB(B1, 1, 1); PG8_SCHED; PG8_LDA(At, 1, 0); PG8_STAGE(PG8_SA(0, 1), a2 + hstepA, voffA);
            PG8_WAIT_V(8); PG8_WAIT_L(0); PG8_BAR; PG8_MMA(0, 0, At, B0); PG8_MMA(0, 1, At, B1); PG8_BAR; PG8_SCHED;
            PG8_LDA(At, 1, 1); PG8_STAGE(PG8_SB(1, 0), b3, voffB); PG8_STAGE(PG8_SB(1, 1), b3 + hstepB, voffB); PG8_STAGE(PG8_SA(1, 0), a3, voffA);
            PG8_WAIT_V(8); PG8_WAIT_L(0); PG8_BAR; PG8_MMA(1, 0, At, B0); PG8_MMA(1, 1, At, B1); PG8_BAR; PG8_SCHED;
        }
        if (wr == 0) PG8_BAR;
        { GET_TID(wid); const int l_ = tid_ & 63; E(acc, cur, wr, wc, l_ & 15, l_ >> 4); }
        if (!has_next) break;
        PG8_IDS();
#pragma unroll
        for (int a = 0; a < 2; ++a)
#pragma unroll
            for (int b = 0; b < 2; ++b)
#pragma unroll
                for (int m = 0; m < 4; ++m)
#pragma unroll
                    for (int n = 0; n < 2; ++n) acc[a][b][m][n] = (f32x4){0.f, 0.f, 0.f, 0.f};
        cur = nxt; cA = nA; cB = nB; ++ui;
        if (wr == 1) PG8_BAR;
    }
    PG8_WAIT_V(0);
    PG8_BAR;
#undef PG8_IDS
#undef PG8_SA
#undef PG8_SB
#undef PG8_STAGE
#undef PG8_LDA
#undef PG8_LDB
#undef PG8_MMA
#undef PG8_WAIT_V
#undef PG8_WAIT_L
#undef PG8_BAR
#undef PG8_SCHED
}
}
using pg8::Unit;
typedef const f32x4 (&AccRef)[2][2][4][2];

#define EFENCE() asm volatile("" ::: "memory")
#define EROW(u, ai, m) ((u).pm * 256 + (ai) * 128 + wr * 64 + (m) * 16 + fr)
DI float rstd16(const float* ssq, int row, int fq) {
    const f32x4 v = *(const f32x4*)(ssq + (size_t)row * 16 + fq * 4);
    float s = (v.x + v.y) + (v.z + v.w); s += shx(s, 16); s += shx(s, 32);
    return __builtin_amdgcn_rsqf(s * (1.0f / 1024.0f) + EPS);
}
DI float sum4q(float s) { s += shx(s, 16); s += shx(s, 32); return s; }
DI float sq4(const f32x4& v) { return (v.x * v.x + v.y * v.y) + (v.z * v.z + v.w * v.w); }
DI u32x4 pk8(const f32x4& a, const f32x4& b) { u32x4 w; w.x = cvtpk(a.x, a.y); w.y = cvtpk(a.z, a.w); w.z = cvtpk(b.x, b.y); w.w = cvtpk(b.z, b.w); return w; }

struct EpiSwiglu {
    const float* ssq; bf16_t* hid;
    DI void operator()(AccRef acc, const Unit& u, int wr, int wc, int fr, int fq) const {
        float rsv[2][4];
#pragma unroll
        for (int ai = 0; ai < 2; ++ai)
#pragma unroll
            for (int m = 0; m < 4; ++m) rsv[ai][m] = rstd16(ssq, EROW(u, ai, m), fq);
#pragma unroll
        for (int ai = 0; ai < 2; ++ai)
#pragma unroll
            for (int m = 0; m < 4; ++m) { EFENCE();
                const int row = EROW(u, ai, m); const float rs = rsv[ai][m];
                f32x4 o[2];
#pragma unroll
                for (int n = 0; n < 2; ++n) { const f32x4 g = acc[ai][0][m][n] * rs, v = acc[ai][1][m][n] * rs;
#pragma unroll
                    for (int k = 0; k < 4; ++k) o[n][k] = g[k] * __builtin_amdgcn_rcpf(1.0f + __builtin_amdgcn_exp2f(-LOG2E * g[k])) * v[k]; }
                *(u32x4*)(hid + (size_t)row * FF + u.pn * 128 + wc * 32 + 8 * fq) = pk8(o[0], o[1]);
            }
    }
};
struct EpiResid {
    const float* xin; float* xout; bf16_t* xb; float* ssq; float alpha;
    DI void operator()(AccRef acc, const Unit& u, int wr, int wc, int fr, int fq) const {
#pragma unroll
        for (int ai = 0; ai < 2; ++ai)
#pragma unroll
            for (int m = 0; m < 4; ++m) { if ((m & 1) == 0) EFENCE();
                const int row = EROW(u, ai, m); float ss = 0.f;
#pragma unroll
                for (int bj = 0; bj < 2; ++bj) {
                    const size_t off = (size_t)row * DM + u.pn * 256 + bj * 128 + wc * 32 + 8 * fq;
                    f32x4 x0 = *(const f32x4*)(xin + off), x1 = *(const f32x4*)(xin + off + 4);
                    x0 += acc[ai][bj][m][0] * alpha; x1 += acc[ai][bj][m][1] * alpha;
                    *(f32x4*)(xout + off) = x0; *(f32x4*)(xout + off + 4) = x1;
                    *(u32x4*)(xb + off) = pk8(x0, x1); ss += sq4(x0) + sq4(x1);
                }
                ss = sum4q(ss);
                if (fq == 0) ssq[(size_t)row * 16 + u.pn * 4 + wc] = ss;
            }
    }
};
struct EpiEvenIn {
    const float* ssq; const float* qn; const float* kn; const float* ropeA; bf16_t *Q, *K, *V, *F;
    DI void operator()(AccRef acc, const Unit& u, int wr, int wc, int fr, int fq) const {
        const int kind = u.pn >> 1;
        float rsv[2][4];
#pragma unroll
        for (int ai = 0; ai < 2; ++ai)
#pragma unroll
            for (int m = 0; m < 4; ++m) rsv[ai][m] = rstd16(ssq, EROW(u, ai, m), fq);
#pragma unroll
        for (int ai = 0; ai < 2; ++ai)
#pragma unroll
            for (int m = 0; m < 4; ++m) { EFENCE();
                const int row = EROW(u, ai, m); const float rs = rsv[ai][m];
                f32x4 v[2][2];
#pragma unroll
                for (int bj = 0; bj < 2; ++bj)
#pragma unroll
                    for (int n = 0; n < 2; ++n) v[bj][n] = acc[ai][bj][m][n] * rs;
                if (u.pn == 6) {
#pragma unroll
                    for (int bj = 0; bj < 2; ++bj) *(u32x4*)(F + (size_t)row * 256 + bj * 128 + wc * 32 + 8 * fq) = pk8(v[bj][0], v[bj][1]);
                } else {
                    const int head = 4 * (u.pn & 1) + wc;
                    if (kind < 2) {
                        float ss = sq4(v[0][0]) + sq4(v[0][1]) + sq4(v[1][0]) + sq4(v[1][1]); ss = sum4q(ss);
                        const float hr = 1.0f / sqrtf(ss * (1.0f / 64.0f) + EPS);
                        const float* gn = kind == 0 ? qn : kn;
#pragma unroll
                        for (int bj = 0; bj < 2; ++bj)
#pragma unroll
                            for (int n = 0; n < 2; ++n) { const f32x4 gv = *(const f32x4*)(gn + 32 * bj + 8 * fq + 4 * n); v[bj][n] = v[bj][n] * hr * gv; }
                        f32x4 pr[2];
#pragma unroll
                        for (int n = 0; n < 2; ++n)
#pragma unroll
                            for (int k = 0; k < 4; ++k) pr[n][k] = shx(v[0][n][k], 16);
                        if (fq < 2) {
                            const float* rp = ropeA + (size_t)row * 16;
#pragma unroll
                            for (int n = 0; n < 2; ++n) { const f32x4 c = *(const f32x4*)(rp + 4 * n), s = *(const f32x4*)(rp + 8 + 4 * n);
                                v[0][n] = fq == 0 ? (v[0][n] * c - pr[n] * s) : (v[0][n] * c + pr[n] * s); }
                        }
                        if (kind == 0) {
#pragma unroll
                            for (int bj = 0; bj < 2; ++bj)
#pragma unroll
                                for (int n = 0; n < 2; ++n) v[bj][n] = v[bj][n] * (0.125f * LOG2E);
                        }
                    }
                    bf16_t* dst = Q + (size_t)kind * (32u << 20);
#pragma unroll
                    for (int bj = 0; bj < 2; ++bj) *(u32x4*)(dst + (size_t)row * 512 + head * 64 + 32 * bj + 8 * fq) = pk8(v[bj][0], v[bj][1]);
                }
            }
    }
};
struct EpiOddIn {
    const float* ssq; bf16_t *QLAT, *KVLAT, *UA; float *KPE, *SSQQ, *SSQKV, *SSPE;
    DI void operator()(AccRef acc, const Unit& u, int wr, int wc, int fr, int fq) const {
        float rsv[2][4];
#pragma unroll
        for (int ai = 0; ai < 2; ++ai)
#pragma unroll
            for (int m = 0; m < 4; ++m) rsv[ai][m] = rstd16(ssq, EROW(u, ai, m), fq);
#pragma unroll
        for (int ai = 0; ai < 2; ++ai)
#pragma unroll
            for (int m = 0; m < 4; ++m) { EFENCE();
                const int row = EROW(u, ai, m); const float rs = rsv[ai][m];
                f32x4 v[2][2];
#pragma unroll
                for (int bj = 0; bj < 2; ++bj)
#pragma unroll
                    for (int n = 0; n < 2; ++n) v[bj][n] = acc[ai][bj][m][n] * rs;
                if (u.pn == 0) {
                    float ss = sq4(v[0][0]) + sq4(v[0][1]) + sq4(v[1][0]) + sq4(v[1][1]); ss = sum4q(ss);
#pragma unroll
                    for (int bj = 0; bj < 2; ++bj) *(u32x4*)(QLAT + (size_t)row * 256 + bj * 128 + wc * 32 + 8 * fq) = pk8(v[bj][0], v[bj][1]);
                    if (fq == 0) SSQQ[(size_t)row * 4 + wc] = ss;
                } else if (u.pn == 1) {
                    float ss = sq4(v[0][0]) + sq4(v[0][1]); ss = sum4q(ss);
                    float sp = sq4(v[1][0]) + sq4(v[1][1]); sp = sum4q(sp);
                    *(u32x4*)(KVLAT + (size_t)row * 128 + wc * 32 + 8 * fq) = pk8(v[0][0], v[0][1]);
                    if (fq == 0) SSQKV[(size_t)row * 4 + wc] = ss;
                    if (wc == 0) { *(f32x4*)(KPE + (size_t)row * 32 + 8 * fq) = v[1][0]; *(f32x4*)(KPE + (size_t)row * 32 + 8 * fq + 4) = v[1][1]; if (fq == 0) SSPE[row] = sp; }
                } else {
                    const int chunk = row >> 6, s = row & 63;
#pragma unroll
                    for (int bj = 0; bj < 2; ++bj) { const int g = 8 * bj + 2 * wc + (fq >> 1), h0 = 8 * (fq & 1);
                        *(u32x4*)(UA + ((size_t)g * 1024 + chunk) * 1280 + s * 16 + h0) = pk8(v[bj][0], v[bj][1]); }
                }
            }
    }
};
struct EpiQup {
    const float* SSQQ; bf16_t* QH;
    DI void operator()(AccRef acc, const Unit& u, int wr, int wc, int fr, int fq) const {
#pragma unroll
        for (int ai = 0; ai < 2; ++ai)
#pragma unroll
            for (int m = 0; m < 4; ++m) { EFENCE();
                const int row = EROW(u, ai, m); const f32x4 p = *(const f32x4*)(SSQQ + (size_t)row * 4);
                const float rs = 1.0f / sqrtf(((p.x + p.y) + (p.z + p.w)) * (1.0f / 256.0f) + EPS);
#pragma unroll
                for (int bj = 0; bj < 2; ++bj) *(u32x4*)(QH + (size_t)row * 768 + u.pn * 256 + bj * 128 + wc * 32 + 8 * fq) = pk8(acc[ai][bj][m][0] * rs, acc[ai][bj][m][1] * rs);
            }
    }
};
struct EpiKVup {
    const float *SSQKV, *SSPE, *KPE, *kn, *ropeC; bf16_t *KH, *VH;
    DI void operator()(AccRef acc, const Unit& u, int wr, int wc, int fr, int fq) const {
        const int head = 2 * u.pn + (wc >> 1);
#pragma unroll
        for (int ai = 0; ai < 2; ++ai)
#pragma unroll
            for (int m = 0; m < 4; ++m) { EFENCE();
                const int row = EROW(u, ai, m); const f32x4 p = *(const f32x4*)(SSQKV + (size_t)row * 4);
                const float rs = 1.0f / sqrtf(((p.x + p.y) + (p.z + p.w)) * (1.0f / 128.0f) + EPS);
                f32x4 v[2][2];
#pragma unroll
                for (int bj = 0; bj < 2; ++bj)
#pragma unroll
                    for (int n = 0; n < 2; ++n) v[bj][n] = acc[ai][bj][m][n] * rs;
                float ss = sq4(v[0][0]) + sq4(v[0][1]) + sq4(v[1][0]) + sq4(v[1][1]); ss = sum4q(ss);
                if (wc & 1) {
#pragma unroll
                    for (int bj = 0; bj < 2; ++bj) *(u32x4*)(VH + (size_t)row * 512 + head * 64 + 32 * bj + 8 * fq) = pk8(v[bj][0], v[bj][1]);
                } else {
                    const float kr = 1.0f / sqrtf((ss + SSPE[row]) * (1.0f / 96.0f) + EPS);
                    bf16_t* kd = KH + (size_t)row * 768 + head * 96;
#pragma unroll
                    for (int bj = 0; bj < 2; ++bj) { const f32x4 g0 = *(const f32x4*)(kn + 32 * bj + 8 * fq), g1 = *(const f32x4*)(kn + 32 * bj + 8 * fq + 4);
                        *(u32x4*)(kd + 32 * bj + 8 * fq) = pk8(v[bj][0] * kr * g0, v[bj][1] * kr * g1); }
                    const f32x4 lo = *(const f32x4*)(KPE + (size_t)row * 32 + 4 * fq) * kr * *(const f32x4*)(kn + 64 + 4 * fq);
                    const f32x4 hi = *(const f32x4*)(KPE + (size_t)row * 32 + 16 + 4 * fq) * kr * *(const f32x4*)(kn + 80 + 4 * fq);
                    const f32x4 c = *(const f32x4*)(ropeC + (size_t)row * 32 + 4 * fq), s = *(const f32x4*)(ropeC + (size_t)row * 32 + 16 + 4 * fq);
                    const f32x4 olo = lo * c - hi * s, ohi = hi * c + lo * s;
                    u32x2 w0, w1; w0.x = cvtpk(olo.x, olo.y); w0.y = cvtpk(olo.z, olo.w); w1.x = cvtpk(ohi.x, ohi.y); w1.y = cvtpk(ohi.z, ohi.w);
                    *(u32x2*)(kd + 64 + 4 * fq) = w0; *(u32x2*)(kd + 80 + 4 * fq) = w1;
                }
            }
    }
};
struct EpiE {
    float* EB;
    DI void operator()(AccRef acc, const Unit& u, int wr, int wc, int fr, int fq) const {
#pragma unroll
        for (int ai = 0; ai < 2; ++ai)
#pragma unroll
            for (int m = 0; m < 4; ++m) { EFENCE(); const int row = EROW(u, ai, m);
#pragma unroll
                for (int bj = 0; bj < 2; ++bj) { float* d = EB + (size_t)row * 256 + bj * 128 + wc * 32 + 8 * fq; *(f32x4*)d = acc[ai][bj][m][0]; *(f32x4*)(d + 4) = acc[ai][bj][m][1]; } }
    }
};
DI float gelu_tanh(float y) { const float a = 0.7978845608028654f * (y + 0.044715f * y * y * y); return y * __builtin_amdgcn_rcpf(1.0f + __builtin_amdgcn_exp2f(-2.0f * LOG2E * a)); }
struct EpiY {
    bf16_t* Z;
    DI void operator()(AccRef acc, const Unit& u, int wr, int wc, int fr, int fq) const {
        const int g = u.pm >> 2, pni = u.pn & 3;
#pragma unroll
        for (int ai = 0; ai < 2; ++ai)
#pragma unroll
            for (int m = 0; m < 4; ++m) { EFENCE(); const int chunk = EROW(u, ai, m) - g * 1024;
#pragma unroll
                for (int bj = 0; bj < 2; ++bj) { const int n0 = pni * 256 + bj * 128 + wc * 32 + 8 * fq, tt = n0 >> 4, h0 = n0 & 15;
                    f32x4 a = acc[ai][bj][m][0], b = acc[ai][bj][m][1];
#pragma unroll
                    for (int k = 0; k < 4; ++k) { a[k] = gelu_tanh(a[k]); b[k] = gelu_tanh(b[k]); }
                    *(u32x4*)(Z + ((size_t)chunk * 64 + tt) * 256 + g * 16 + h0) = pk8(a, b); } }
    }
};
struct EpiGLU {
    const bf16_t* Z; const float* bglu; bf16_t* MG;
    DI void operator()(AccRef acc, const Unit& u, int wr, int wc, int fr, int fq) const {
#pragma unroll
        for (int ai = 0; ai < 2; ++ai)
#pragma unroll
            for (int m = 0; m < 4; ++m) { EFENCE(); const int row = EROW(u, ai, m);
#pragma unroll
                for (int bj = 0; bj < 2; ++bj) { const int col = bj * 128 + wc * 32 + 8 * fq;
                    const u32x4 zz = *(const u32x4*)(Z + (size_t)row * 256 + col);
                    const f32x4 b0 = *(const f32x4*)(bglu + col), b1 = *(const f32x4*)(bglu + col + 4);
                    f32x4 a = acc[ai][bj][m][0] + b0, b = acc[ai][bj][m][1] + b1;
                    const float z[8] = {bflo(zz.x), bfhi(zz.x), bflo(zz.y), bfhi(zz.y), bflo(zz.z), bfhi(zz.z), bflo(zz.w), bfhi(zz.w)};
#pragma unroll
                    for (int k = 0; k < 4; ++k) { a[k] = z[k] * __builtin_amdgcn_rcpf(1.0f + __builtin_amdgcn_exp2f(-LOG2E * a[k])); b[k] = z[4 + k] * __builtin_amdgcn_rcpf(1.0f + __builtin_amdgcn_exp2f(-LOG2E * b[k])); }
                    *(u32x4*)(MG + (size_t)row * 768 + 512 + col) = pk8(a, b); } }
    }
};

struct Args { const float* in[34]; float* out; unsigned char* ws; int ph_lo, ph_hi, rmask, pad; };

DI float wave_sum(float v) {
#pragma unroll
    for (int o = 1; o < 64; o <<= 1) v += shx(v, o);
    return v;
}
DI void xpose_item(const float* W, int ldw, int c0, const float* gain, bf16_t* WT, int K, int n0, int k0, LAS float* scr, int lane) {
#pragma unroll 16
    for (int i = 0; i < 32; ++i) { const int kk = 2 * i + (lane >> 5);
        float v = 0.f; if (W) { v = W[(size_t)(k0 + kk) * ldw + c0 + (lane & 31)]; if (gain) v *= gain[k0 + kk]; }
        scr[kk * 33 + (lane & 31)] = v; }
    const int c = lane & 7;
#pragma unroll
    for (int j = 0; j < 4; ++j) { const int n = (lane >> 3) + 8 * j; const LAS float* s = scr + (8 * c) * 33 + n;
        u32x4 o; o.x = cvtpk(s[0 * 33], s[1 * 33]); o.y = cvtpk(s[2 * 33], s[3 * 33]); o.z = cvtpk(s[4 * 33], s[5 * 33]); o.w = cvtpk(s[6 * 33], s[7 * 33]);
        *(u32x4*)(WT + (size_t)(n0 + n) * K + k0 + 8 * c) = o; }
}

DI void p0_weights(const Args& A, LAS unsigned char* lds, const int wv) {
    GET_TID(wv); const int lane = tid_ & 63, wave = wv, gw = blockIdx.x * 8 + wave, NGW = gridDim.x * 8;
    LAS float* scr = (LAS float*)(lds + wave * 16384);
    unsigned char* ws = A.ws;
    constexpr int I_GU = 176 * 16, I_DN = 32 * 44, I_FFN = I_GU + I_DN;
    constexpr int I_EIN = 56 * 16, I_EOUT = 32 * 12, I_EV = I_EIN + I_EOUT;
    constexpr int I_OIN = 24 * 16, I_QUP = 24 * 4, I_KVUP = 32 * 2, I_OOUT = 32 * 12, I_GLU = 8 * 4, I_OD = I_OIN + I_QUP + I_KVUP + I_OOUT + I_GLU;
    constexpr int NITEMS = 8 * I_FFN + 2 * I_EV + 2 * I_OD;
    for (int it = gw; it < NITEMS; it += NGW) {
        int r = it;
        if (r < 8 * I_FFN) {
            const int lf = r / I_FFN; r -= lf * I_FFN; const int l = lf >> 1, f = lf & 1;
            bf16_t* gu = (bf16_t*)(ws + WS_WFFN + lf * WFFN_STRIDE); bf16_t* dn = gu + (size_t)5632 * 1024;
            if (r < I_GU) { const int nb = r % 176, kb = r / 176, n0 = nb * 32, tile = n0 >> 8, w = n0 & 255, bj = w >> 7, j = w & 127;
                const float* W = INP((f ? 8 : 3) + bj) + (size_t)l * DM * FF;
                xpose_item(W, FF, tile * 128 + j, INP(f ? 7 : 2) + l * DM, gu, DM, n0, kb * 64, scr, lane);
            } else { r -= I_GU; const int nb = r % 32, kb = r / 32;
                xpose_item(INP(f ? 10 : 5) + (size_t)l * FF * DM, DM, nb * 32, nullptr, dn, FF, nb * 32, kb * 64, scr, lane); }
            continue;
        }
        r -= 8 * I_FFN;
        if (r < 2 * I_EV) {
            const int i = r / I_EV; r -= i * I_EV;
            bf16_t* win = (bf16_t*)(ws + WS_WEVEN + i * WEVEN_STRIDE); bf16_t* wout = win + (size_t)1792 * 1024;
            if (r < I_EIN) { const int nb = r % 56, kb = r / 56, n0 = nb * 32, tile = n0 >> 8, w = n0 & 255; int c0;
                if (tile < 6) { const int kind = tile >> 1, bj = w >> 7, wc = (w & 127) >> 5, head = 4 * (tile & 1) + wc; c0 = kind * 512 + head * 64 + 32 * bj; } else c0 = 1536 + w;
                xpose_item(INP(11) + (size_t)i * DM * 1792, 1792, c0, INP(6) + (2 * i) * DM, win, DM, n0, kb * 64, scr, lane);
            } else { r -= I_EIN; const int nb = r % 32, kb = r / 32;
                const bool zk = (ZMODE == 1 && kb * 64 < 512) || (ZMODE == 2 && kb * 64 >= 512);
                xpose_item(zk ? nullptr : INP(12) + (size_t)i * 768 * DM, DM, nb * 32, nullptr, wout, 768, nb * 32, kb * 64, scr, lane); }
            continue;
        }
        r -= 2 * I_EV;
        {
            const int i = r / I_OD; r -= i * I_OD;
            unsigned char* wb = ws + WS_WODD + i * WODD_STRIDE2;
            if (r < I_OIN) { const int nb = r % 24, kb = r / 24, n0 = nb * 32; const float* W = INP(16) + (size_t)i * DM * 672; int c0 = n0;
                if (n0 >= 416 && n0 < 512) W = nullptr; else if (n0 >= 512) c0 = 416 + (n0 - 512);
                xpose_item(W, 672, c0, INP(6) + (2 * i + 1) * DM, (bf16_t*)(wb + WO_IN), DM, n0, kb * 64, scr, lane); continue; }
            r -= I_OIN;
            if (r < I_QUP) { const int nb = r % 24, kb = r / 24;
                xpose_item(INP(19) + (size_t)i * 256 * 768, 768, nb * 32, INP(18) + i * 256, (bf16_t*)(wb + WO_Q), 256, nb * 32, kb * 64, scr, lane); continue; }
            r -= I_QUP;
            if (r < I_KVUP) { const int nb = r % 32, kb = r / 32, n0 = nb * 32, pn = n0 >> 8, w = n0 & 255, bj = w >> 7, wc = (w & 127) >> 5;
                const int head = 2 * pn + (wc >> 1), c0 = head * 128 + (wc & 1) * 64 + 32 * bj;
                xpose_item(INP(21) + (size_t)i * 128 * 1024, 1024, c0, INP(20) + i * 128, (bf16_t*)(wb + WO_KV), 128, n0, kb * 64, scr, lane); continue; }
            r -= I_KVUP;
            if (r < I_OOUT) { const int nb = r % 32, kb = r / 32;
                xpose_item(INP(17) + (size_t)i * 768 * DM, DM, nb * 32, nullptr, (bf16_t*)(wb + WO_OUT), 768, nb * 32, kb * 64, scr, lane); continue; }
            r -= I_OOUT;
            { const int nb = r % 8, kb = r / 8;
                xpose_item(INP(32) + (size_t)i * 256 * 256, 256, nb * 32, nullptr, (bf16_t*)(wb + WO_GLU), 256, nb * 32, kb * 64, scr, lane); }
        }
    }
}

DI void p0_rows(const Args& A, const int wv) {
    GET_TID(wv); const int lane = tid_ & 63, gw = blockIdx.x * 8 + wv, NGW = gridDim.x * 8;
    const float* x = INP(0); bf16_t* XB = (bf16_t*)(A.ws + WS_XB); float* SSQ = (float*)(A.ws + WS_SSQ);
    float* ropeA = (float*)(A.ws + WS_ROPEA); float* ropeC = (float*)(A.ws + WS_ROPEC); const int* pos = (const int*)INP(1);
    for (int row = gw; row < T; row += NGW) {
        const f32x4* xr = (const f32x4*)(x + (size_t)row * DM) + lane; float s = 0.f;
        unsigned long long* o8 = (unsigned long long*)(XB + (size_t)row * DM) + lane;
#pragma unroll
        for (int j = 0; j < 4; ++j) { const f32x4 v = xr[64 * j]; s += sq4(v); o8[64 * j] = (unsigned long long)cvtpk(v.x, v.y) | ((unsigned long long)cvtpk(v.z, v.w) << 32); }
        s = wave_sum(s);
        if (lane < 16) SSQ[(size_t)row * 16 + lane] = lane == 0 ? s : 0.f;
        const float p = (float)pos[row];
        if (lane < 8) { const float f = powf(500000.0f, -(float)(2 * lane) / 16.0f); const float a = p * f; ropeA[(size_t)row * 16 + lane] = cosf(a); ropeA[(size_t)row * 16 + 8 + lane] = sinf(a); }
        else if (lane >= 16 && lane < 32) { const int i = lane - 16; const float f = powf(500000.0f, -(float)(2 * i) / 32.0f); const float a = p * f; ropeC[(size_t)row * 32 + i] = cosf(a); ropeC[(size_t)row * 32 + 16 + i] = sinf(a); }
    }
}

DI void p0_fconst(const Args& A, const int wv) {
    GET_TID(wv); const int gtid = blockIdx.x * 512 + tid_, NT_ = gridDim.x * 512;
    unsigned char* fc = A.ws + WS_FCONST;
    bf16_t* d128c = (bf16_t*)(fc + FC_D128C); bf16_t* d128ns = (bf16_t*)(fc + FC_D128NS);
    bf16_t* d64c = (bf16_t*)(fc + FC_D64C); bf16_t* d64s = (bf16_t*)(fc + FC_D64S); bf16_t* d64ns = (bf16_t*)(fc + FC_D64NS);
    float* tw = (float*)(fc + FC_TW); bf16_t* PT = (bf16_t*)(fc + FC_PT); bf16_t* QT = (bf16_t*)(fc + FC_QT);
    const float TWO_PI = 6.283185307179586f;
    for (int e = gtid; e < 16384; e += NT_) { const int k = e >> 7, s = e & 127; const float a = TWO_PI * (float)((k * s) & 127) / 128.0f;
        d128c[e] = (bf16_t)(cvtpk(cosf(a), 0.f) & 0xffff); d128ns[e] = (bf16_t)(cvtpk(-sinf(a), 0.f) & 0xffff); }
    for (int e = gtid; e < 4096; e += NT_) { const int k = e >> 6, s = e & 63; const float a = TWO_PI * (float)((k * s) & 63) / 64.0f;
        d64c[e] = (bf16_t)(cvtpk(cosf(a), 0.f) & 0xffff); d64s[e] = (bf16_t)(cvtpk(sinf(a), 0.f) & 0xffff); d64ns[e] = (bf16_t)(cvtpk(-sinf(a), 0.f) & 0xffff); }
    for (int e = gtid; e < 8192; e += NT_) { const float a = TWO_PI * (float)e / 8192.0f; tw[2 * e] = cosf(a); tw[2 * e + 1] = sinf(a); }
    const float scale = 1.0f / sqrtf(8192.0f * 64.0f);
    for (int e = gtid; e < 2 * 4 * 64 * 64; e += NT_) {
        const int c = e & 63, d = (e >> 6) & 63, g = (e >> 12) & 3, ie = e >> 14;
        const float* M = INP(15) + ((size_t)(ie * 4 + g) * 64) * 64; float p = 0.f, q = 0.f;
        for (int l = 0; l < 64; ++l) { const float a = TWO_PI * (float)((l * c) & 63) / 64.0f; const float mv = M[l * 64 + d]; p += cosf(a) * mv; q += sinf(a) * mv; }
        PT[e] = (bf16_t)(cvtpk(p * scale, 0.f) & 0xffff); QT[e] = (bf16_t)(cvtpk(q * scale, 0.f) & 0xffff);
    }
}

DI void p0_s5tab(const Args& A, LAS unsigned char* lds, const int wv) {
    LAS f32x2* LPs = (LAS f32x2*)lds;
    LAS f32x2* BBs = (LAS f32x2*)(lds + 33280);
    LAS f32x2* Cs = (LAS f32x2*)(lds + 33280 + 8192);
    float* Ktab = (float*)(A.ws + WS_S5TAB + S5_KTAB); f32x2* LPg = (f32x2*)(A.ws + WS_S5TAB + S5_LP); f32x2* BBg = (f32x2*)(A.ws + WS_S5TAB + S5_BB);
    GET_TID(wv); const int tid = tid_;
    for (int task = blockIdx.x; task < 256; task += gridDim.x) {
        const int idg = task >> 2, qtr = task & 3;
        const float step = expf(INP(26)[idg]);
        const float* lre = INP(24) + idg * 64; const float* lim = INP(25) + idg * 64;
        for (int e = tid; e < 64 * 65; e += 512) { const int p = e / 65, tau = e % 65; const float ar = lre[p] * step * (float)tau, ai = lim[p] * step * (float)tau;
            const float mg = expf(ar); f32x2 v; v.x = mg * cosf(ai); v.y = mg * sinf(ai); LPs[e] = v; if (qtr == 0) LPg[(size_t)idg * 4160 + e] = v; }
        for (int e = tid; e < 1024; e += 512) { const int hh = e >> 6, p = e & 63; f32x2 c; c.x = INP(29)[(size_t)idg * 1024 + e]; c.y = INP(30)[(size_t)idg * 1024 + e]; Cs[hh * 64 + p] = c; }
        __syncthreads();
        for (int e = tid; e < 1024; e += 512) { const int p = e >> 4; const f32x2 lb = LPs[p * 65 + 1]; const float lr = lre[p], li = lim[p];
            const float nr = lb.x - 1.0f, ni = lb.y, den = lr * lr + li * li; const float qr = (nr * lr + ni * li) / den, qi = (ni * lr - nr * li) / den;
            const float br = INP(27)[(size_t)idg * 1024 + e], bi = INP(28)[(size_t)idg * 1024 + e];
            f32x2 v; v.x = qr * br - qi * bi; v.y = qr * bi + qi * br; BBs[e] = v; if (qtr == 0) BBg[(size_t)idg * 1024 + e] = v; }
        __syncthreads();
        for (int e = qtr * 4096 + tid; e < (qtr + 1) * 4096; e += 512) { const int tau = e >> 8, hp = (e >> 4) & 15, h = e & 15; float acc = 0.f;
            for (int p = 0; p < 64; ++p) { const f32x2 l = LPs[p * 65 + tau], b = BBs[p * 16 + h], c = Cs[hp * 64 + p];
                const float wr_ = l.x * b.x - l.y * b.y, wi_ = l.x * b.y + l.y * b.x; acc += c.x * wr_ - c.y * wi_; }
            Ktab[(size_t)idg * 16384 + e] = acc; }
        __syncthreads();
    }
}
DI void p0_s5mats(const Args& A, const int wv) {
    GET_TID(wv); const int gtid = blockIdx.x * 512 + tid_, NT_ = gridDim.x * 512;
    const float* Ktab = (const float*)(A.ws + WS_S5TAB + S5_KTAB); const f32x2* LPg = (const f32x2*)(A.ws + WS_S5TAB + S5_LP); const f32x2* BBg = (const f32x2*)(A.ws + WS_S5TAB + S5_BB);
    for (int e = gtid; e < 2 * 16 * 1024 * 160; e += NT_) {
        const int k8 = e % 160, n = (e / 160) & 1023, g = (e / (160 * 1024)) & 15, i = e / (160 * 1024 * 16);
        const int tt = n >> 4, hp = n & 15, k = k8 * 8; float v[8];
        if (k < 1024) { const int s = k >> 4, h0 = k & 15;
            if (s == tt) { const float* kf = Ktab + ((size_t)((i * 2 + 0) * 16 + g) * 64 + 0) * 256 + hp * 16 + h0; const float* kb = Ktab + ((size_t)((i * 2 + 1) * 16 + g) * 64 + 0) * 256 + hp * 16 + h0;
                for (int j = 0; j < 8; ++j) v[j] = kf[j] + kb[j] + ((h0 + j) == hp ? INP(31)[i * 256 + g * 16 + hp] : 0.f);
            } else { const int dir = s < tt ? 0 : 1, tau = s < tt ? tt - s : s - tt; const float* kt = Ktab + ((size_t)((i * 2 + dir) * 16 + g) * 64 + tau) * 256 + hp * 16 + h0;
                for (int j = 0; j < 8; ++j) v[j] = kt[j]; }
        } else { const int kk = k - 1024, dir = kk >> 7, p0 = (kk & 127) >> 1; const int idg = (i * 2 + dir) * 16 + g; const int pw = dir == 0 ? tt + 1 : 64 - tt;
            for (int j = 0; j < 4; ++j) { const int p = p0 + j; const f32x2 w = LPg[(size_t)idg * 4160 + p * 65 + pw];
                const float cr = INP(29)[(size_t)idg * 1024 + hp * 64 + p], ci = INP(30)[(size_t)idg * 1024 + hp * 64 + p];
                v[2 * j] = cr * w.x - ci * w.y; v[2 * j + 1] = -(cr * w.y + ci * w.x); } }
        bf16_t* dst = (bf16_t*)(A.ws + WS_WODD + i * WODD_STRIDE2 + WO_TMAT) + ((size_t)g * 1024 + n) * 1280 + k;
        u32x4 o; o.x = cvtpk(v[0], v[1]); o.y = cvtpk(v[2], v[3]); o.z = cvtpk(v[4], v[5]); o.w = cvtpk(v[6], v[7]); *(u32x4*)dst = o;
    }
    for (int e = gtid; e < 2 * 16 * 256 * 128; e += NT_) {
        const int k8 = e & 127, n = (e >> 7) & 255, g = (e >> 15) & 15, i = e >> 19;
        const int dir = n >> 7, p = (n & 127) >> 1, ri = n & 1, k = k8 * 8, s = k >> 4, h0 = k & 15; const int idg = (i * 2 + dir) * 16 + g;
        const f32x2 w = LPg[(size_t)idg * 4160 + p * 65 + (dir == 0 ? 63 - s : s)]; float v[8];
        for (int j = 0; j < 8; ++j) { const f32x2 b = BBg[(size_t)idg * 1024 + p * 16 + h0 + j]; v[j] = ri == 0 ? (w.x * b.x - w.y * b.y) : (w.x * b.y + w.y * b.x); }
        bf16_t* dst = (bf16_t*)(A.ws + WS_WODD + i * WODD_STRIDE2 + WO_EMAT) + ((size_t)g * 256 + n) * 1024 + k;
        u32x4 o; o.x = cvtpk(v[0], v[1]); o.y = cvtpk(v[2], v[3]); o.z = cvtpk(v[4], v[5]); o.w = cvtpk(v[6], v[7]); *(u32x4*)dst = o;
    }
}

DI void s5_scan(const Args& A, int i, const int wv) {
    GET_TID(wv); const int gtid = blockIdx.x * 512 + tid_, NT_ = gridDim.x * 512;
    const float* EB = (const float*)(A.ws + WS_MIX2 + M2_EB); bf16_t* UA = (bf16_t*)(A.ws + WS_MIX2 + M2_UA);
    for (int e = gtid; e < 8 * 16 * 128; e += NT_) {
        const int dp = e & 127, g = (e >> 7) & 15, b = e >> 11, dir = dp >> 6, p = dp & 63; const int idg = (i * 2 + dir) * 16 + g;
        const float step = expf(INP(26)[idg]); const float ar = INP(24)[idg * 64 + p] * step * 64.0f, ai = INP(25)[idg * 64 + p] * step * 64.0f;
        const float mg = expf(ar), lr = mg * cosf(ai), li = mg * sinf(ai);
        float hr = 0.f, hi = 0.f;
        for (int j0 = 0; j0 < 128; j0 += 8) {
            f32x2 ev[8];
#pragma unroll
            for (int u = 0; u < 8; ++u) { const int jj = j0 + u, j = dir == 0 ? jj : 127 - jj; ev[u] = *(const f32x2*)(EB + ((size_t)g * 1024 + b * 128 + j) * 256 + dir * 128 + 2 * p); }
#pragma unroll
            for (int u = 0; u < 8; ++u) { const int jj = j0 + u, j = dir == 0 ? jj : 127 - jj; const size_t row = (size_t)g * 1024 + b * 128 + j;
                *(unsigned*)(UA + row * 1280 + 1024 + dir * 128 + 2 * p) = cvtpk(hr, hi);
                const float nr = lr * hr - li * hi + ev[u].x, ni = lr * hi + li * hr + ev[u].y; hr = nr; hi = ni; }
        }
    }
}

DI void dilated_phase(const Args& A, LAS unsigned char* lds, int br, const int wv) {
    const int dl = br == 0 ? 1 : (br == 1 ? 4 : 16), L = SEQ / dl;
    const bf16_t* Q = (const bf16_t*)(A.ws + WS_HID + EV_Q); const bf16_t* Kp = (const bf16_t*)(A.ws + WS_HID + EV_K); const bf16_t* V = (const bf16_t*)(A.ws + WS_HID + EV_V);
    bf16_t* MG = (bf16_t*)(A.ws + WS_MERGED); float* LSE = (float*)(A.ws + WS_MIX2 + M2_LSE);
    GET_TID(wv);
    const int tid = tid_, lane = tid & 63, w = wv, r32 = lane & 31, h = lane >> 5, blk = (lane >> 4) & 1, q_ = (lane & 15) >> 2, p_ = lane & 3;
    const int wp = w >> 1, qh = w & 1;
    LAS unsigned char* vb = lds + wp * 27648;
    for (int x = blockIdx.x >> 3; x < 256; x += gridDim.x >> 3) {
        const int b = blockIdx.x & 7, hg = x & 1, y = x >> 1, r = y % dl, n = y / dl, head = hg * 4 + wp;
#pragma unroll
        for (int ps = 0; ps < 12; ++ps) { const int lp = qh * 64 + lane, row = ps * 16 + (lp >> 3), ch = lp & 7; int key = 64 * n - 64 + row; key = key < 0 ? 0 : (key >= L ? L - 1 : key);
            const size_t t = (size_t)b * SEQ + key * dl + r; const u32x4 v = *(const u32x4*)(V + t * 512 + head * 64 + ch * 8); *(LAS u32x4*)(vb + row * 144 + ch * 16) = v; }
        __syncthreads();
        const size_t tq = (size_t)b * SEQ + (64 * n + 32 * qh + r32) * dl + r;
        bf16x8 qf[4];
#pragma unroll
        for (int s = 0; s < 4; ++s) qf[s] = *(const bf16x8*)(Q + tq * 512 + head * 64 + 16 * s + 8 * h);
        const int kb0 = 64 * n - 64 + 32 * qh;
        f32x16 p[5];
        {
            bf16x8 kf[5][4];
#pragma unroll
            for (int kt = 0; kt < 5; ++kt) { int key = kb0 + 32 * kt + r32; key = key < 0 ? 0 : (key >= L ? L - 1 : key); const size_t tk = (size_t)b * SEQ + key * dl + r;
#pragma unroll
                for (int s = 0; s < 4; ++s) kf[kt][s] = *(const bf16x8*)(Kp + tk * 512 + head * 64 + 16 * s + 8 * h); }
#pragma unroll
            for (int kt = 0; kt < 5; ++kt) { f32x16 acc = zero16();
#pragma unroll
                for (int s = 0; s < 4; ++s) acc = MFMA32(kf[kt][s], qf[s], acc);
                p[kt] = acc; }
        }
        float lo_prev = 0.f; u32x2 od_prev[2][4];
        if (br > 0) { lo_prev = LSE[tq * 8 + head];
#pragma unroll
            for (int dt = 0; dt < 2; ++dt)
#pragma unroll
                for (int gq = 0; gq < 4; ++gq) od_prev[dt][gq] = *(const u32x2*)(MG + tq * 768 + head * 64 + 32 * dt + 8 * gq + 4 * h); }
        float mx = -1e30f;
#pragma unroll
        for (int kt = 0; kt < 5; ++kt)
#pragma unroll
            for (int rg = 0; rg < 16; ++rg) { const int jj = 32 * kt + crow(rg, h), key = kb0 + jj; const bool ok = (jj >= r32) && (jj <= r32 + 128) && (key >= 0) && (key < L);
                const float v = ok ? p[kt][rg] : -1e30f; p[kt][rg] = v; mx = fmaxf(mx, v); }
        mx = fmaxf(mx, shx(mx, 32));
        float l = 0.f;
#pragma unroll
        for (int kt = 0; kt < 5; ++kt)
#pragma unroll
            for (int rg = 0; rg < 16; ++rg) { const float v = __builtin_amdgcn_exp2f(p[kt][rg] - mx); p[kt][rg] = v; l += v; }
        l += shx(l, 32);
        f32x16 o[2]; o[0] = zero16(); o[1] = zero16();
#pragma unroll
        for (int kt = 0; kt < 5; ++kt)
#pragma unroll
            for (int s = 0; s < 2; ++s) { const bf16x8 pb = pack8(p[kt], s);
#pragma unroll
                for (int dt = 0; dt < 2; ++dt) { LAS const char* ad = (LAS const char*)vb + (32 * qh + 32 * kt + 16 * s + 4 * h + q_) * 144 + (32 * dt + 16 * blk) * 2 + 8 * p_;
                    const bf16x8 va = cat8(trread(ad), trread(ad + 8 * 144)); o[dt] = MFMA32(va, pb, o[dt]); } }
        const float inv = 1.0f / l; float lse = mx + __builtin_amdgcn_logf(l);
        float wn = inv, wo = 0.f;
        if (br > 0) { const float lo = lo_prev; const float mm = fmaxf(lo, lse); const float eo = __builtin_amdgcn_exp2f(lo - mm), en = __builtin_amdgcn_exp2f(lse - mm); const float den = eo + en;
            wo = eo / den; wn = en / den * inv; lse = mm + __builtin_amdgcn_logf(den); }
#pragma unroll
        for (int dt = 0; dt < 2; ++dt)
#pragma unroll
            for (int gq = 0; gq < 4; ++gq) { bf16_t* dst = MG + tq * 768 + head * 64 + 32 * dt + 8 * gq + 4 * h;
                float v0 = o[dt][4 * gq] * wn, v1 = o[dt][4 * gq + 1] * wn, v2 = o[dt][4 * gq + 2] * wn, v3 = o[dt][4 * gq + 3] * wn;
                if (br > 0) { const u32x2 od = od_prev[dt][gq]; v0 += wo * bflo(od.x); v1 += wo * bfhi(od.x); v2 += wo * bflo(od.y); v3 += wo * bfhi(od.y); }
                u32x2 ww; ww.x = cvtpk(v0, v1); ww.y = cvtpk(v2, v3); if (NOSTORE == 0) *(u32x2*)dst = ww; else if (ww.x == 0x12345678u) *(u32x2*)dst = ww; }
        if (h == 0) LSE[tq * 8 + head] = lse;
        __syncthreads();
    }
}

DI void fnet1_phase(const Args& A, LAS unsigned char* lds, const int wv) {
    const bf16_t* F = (const bf16_t*)(A.ws + WS_HID + EV_F); bf16_t* YP = (bf16_t*)(A.ws + WS_HID + EV_YP);
    const unsigned char* fc = A.ws + WS_FCONST; const bf16_t* d128c = (const bf16_t*)(fc + FC_D128C); const bf16_t* d128ns = (const bf16_t*)(fc + FC_D128NS); const f32x2* tw = (const f32x2*)(fc + FC_TW);
    GET_TID(wv);
    const int tid = tid_, lane = tid & 63, w = wv, r32 = lane & 31, h = lane >> 5, blk = (lane >> 4) & 1, q_ = (lane & 15) >> 2, p_ = lane & 3;
    LAS unsigned char* tb = lds + w * 16384;
    for (int tl = (blockIdx.x >> 3) * 8 + w; tl < 256; tl += (gridDim.x >> 3) * 8) {
        const int b = blockIdx.x & 7, g = tl >> 6, s2 = tl & 63, bg = b * 4 + g;
#pragma unroll
        for (int ps = 0; ps < 16; ++ps) { const int s1 = ps * 8 + (lane >> 3), ch = lane & 7; const size_t t = (size_t)b * SEQ + 64 * s1 + s2;
            const u32x4 v = *(const u32x4*)(F + t * 256 + g * 64 + ch * 8); *(LAS u32x4*)(tb + s1 * 128 + ch * 16) = v; }
        unsigned tro = (unsigned)(size_t)tb;
        asm volatile("s_waitcnt lgkmcnt(0)" : "+v"(tro) :: "memory");
        LAS const char* tbr = (LAS const char*)(size_t)tro;
        for (int mt = 0; mt < 4; ++mt) {
            f32x16 acc[2][2]; acc[0][0] = zero16p(); acc[0][1] = zero16p(); acc[1][0] = zero16p(); acc[1][1] = zero16p();
            bf16x8 acv[8], asv[8];
#pragma unroll
            for (int ks = 0; ks < 8; ++ks) { acv[ks] = *(const bf16x8*)(d128c + (32 * mt + r32) * 128 + 16 * ks + 8 * h); asv[ks] = *(const bf16x8*)(d128ns + (32 * mt + r32) * 128 + 16 * ks + 8 * h); }
#pragma unroll
            for (int ks = 0; ks < 8; ++ks) {
                const bf16x8 ac = acv[ks], as = asv[ks];
#pragma unroll
                for (int nt = 0; nt < 2; ++nt) { LAS const char* ad = tbr + (16 * ks + 8 * h + q_) * 128 + (32 * nt + 16 * blk) * 2 + 8 * p_;
                    const bf16x8 bf = cat8(trread(ad), trread(ad + 4 * 128));
                    acc[nt][0] = MFMA32(ac, bf, acc[nt][0]); acc[nt][1] = MFMA32(as, bf, acc[nt][1]); }
            }
#pragma unroll
            for (int rg = 0; rg < 16; ++rg) { const int k1 = 32 * mt + crow(rg, h); const float rev = (float)((k1 * s2) & 8191) * (1.0f / 8192.0f); f32x2 t2; t2.x = __builtin_amdgcn_cosf(rev); t2.y = __builtin_amdgcn_sinf(rev);
#pragma unroll
                for (int nt = 0; nt < 2; ++nt) { const float yr = acc[nt][0][rg], yi = acc[nt][1][rg]; const float zr = yr * t2.x + yi * t2.y, zi = yi * t2.x - yr * t2.y;
                    const unsigned pk = cvtpk(zr, zi); const size_t base = ((size_t)(bg * 128 + k1) * 2) * 4096 + s2 * 64 + 32 * nt + r32;
                    YP[base] = (bf16_t)(pk & 0xffff); YP[base + 4096] = (bf16_t)(pk >> 16); } }
        }
        asm volatile("s_waitcnt lgkmcnt(0)" ::: "memory");
    }
}
DI void fnet2_phase(const Args& A, LAS unsigned char* lds, int ie, const int wv) {
    const bf16_t* YP = (const bf16_t*)(A.ws + WS_HID + EV_YP); bf16_t* MG = (bf16_t*)(A.ws + WS_MERGED);
    const unsigned char* fc = A.ws + WS_FCONST; const bf16_t* d64c = (const bf16_t*)(fc + FC_D64C); const bf16_t* d64s = (const bf16_t*)(fc + FC_D64S); const bf16_t* d64ns = (const bf16_t*)(fc + FC_D64NS);
    const bf16_t* PT = (const bf16_t*)(fc + FC_PT) + (size_t)ie * 4 * 4096; const bf16_t* QT = (const bf16_t*)(fc + FC_QT) + (size_t)ie * 4 * 4096;
    GET_TID(wv);
    const int tid = tid_, lane = tid & 63, w = wv, r32 = lane & 31, h = lane >> 5, blk = (lane >> 4) & 1, q_ = (lane & 15) >> 2, p_ = lane & 3;
    LAS unsigned char* tb = lds + w * 16384;
    for (int tl = (blockIdx.x >> 3) * 8 + w; tl < 512; tl += (gridDim.x >> 3) * 8) {
        const int b = blockIdx.x & 7, g = tl >> 7, k1 = tl & 127, bg = b * 4 + g;
        const unsigned char* src = (const unsigned char*)(YP + ((size_t)(bg * 128 + k1) * 2) * 4096);
#pragma unroll
        for (int ps = 0; ps < 16; ++ps) { const u32x4 v = *(const u32x4*)(src + ps * 1024 + lane * 16); *(LAS u32x4*)(tb + ps * 1024 + lane * 16) = v; }
        unsigned tro = (unsigned)(size_t)tb;
        asm volatile("s_waitcnt lgkmcnt(0)" : "+v"(tro) :: "memory");
        LAS const char* tbr = (LAS const char*)(size_t)tro;
        for (int nt = 0; nt < 2; ++nt) {
            f32x16 xr[2], xi[2]; xr[0] = zero16p(); xr[1] = zero16p(); xi[0] = zero16p(); xi[1] = zero16p();
#pragma unroll
            for (int ks = 0; ks < 4; ++ks) {
                const int off = (32 * nt + r32) * 64 + 16 * ks + 8 * h;
                const bf16x8 bC = *(const bf16x8*)(d64c + off), bS = *(const bf16x8*)(d64s + off), bN = *(const bf16x8*)(d64ns + off);
#pragma unroll
                for (int ct = 0; ct < 2; ++ct) { LAS const char* ad = tbr + (16 * ks + 8 * h + q_) * 128 + (32 * ct + 16 * blk) * 2 + 8 * p_;
                    const bf16x8 aR = cat8(trread(ad), trread(ad + 4 * 128)); const bf16x8 aI = cat8(trread(ad + 8192), trread(ad + 8192 + 4 * 128));
                    xr[ct] = MFMA32(aR, bC, xr[ct]); xr[ct] = MFMA32(aI, bS, xr[ct]); xi[ct] = MFMA32(aI, bC, xi[ct]); xi[ct] = MFMA32(aR, bN, xi[ct]); }
            }
#pragma unroll
            for (int dt = 0; dt < 2; ++dt) {
                f32x16 oa = zero16p();
#pragma unroll
                for (int ct = 0; ct < 2; ++ct)
#pragma unroll
                    for (int s = 0; s < 2; ++s) { const bf16x8 pR = pack8(xr[ct], s), pI = pack8(xi[ct], s);
                        const int po = (g * 64 + 32 * dt + r32) * 64 + 32 * ct + 16 * s + 4 * h;
                        const bf16x8 aP = cat8(*(const s16x4*)(PT + po), *(const s16x4*)(PT + po + 8)), aQ = cat8(*(const s16x4*)(QT + po), *(const s16x4*)(QT + po + 8));
                        oa = MFMA32(aP, pR, oa); oa = MFMA32(aQ, pI, oa); }
                const size_t t = (size_t)b * SEQ + k1 + 128 * (32 * nt + r32);
#pragma unroll
                for (int gq = 0; gq < 4; ++gq) { u32x2 ww; ww.x = cvtpk(oa[4 * gq], oa[4 * gq + 1]); ww.y = cvtpk(oa[4 * gq + 2], oa[4 * gq + 3]);
                    *(u32x2*)(MG + t * 768 + 512 + g * 64 + 32 * dt + 8 * gq + 4 * h) = ww; }
            }
        }
        asm volatile("s_waitcnt lgkmcnt(0)" ::: "memory");
    }
}

DI void mla_phase(const Args& A, LAS unsigned char* lds, int i, const int wv) {
    const bf16_t* QH = (const bf16_t*)(A.ws + WS_HID + OD_QH); const bf16_t* KH = (const bf16_t*)(A.ws + WS_HID + OD_KH); const bf16_t* VH = (const bf16_t*)(A.ws + WS_HID + OD_VH);
    bf16_t* MG = (bf16_t*)(A.ws + WS_MERGED); const float* ropeC = (const float*)(A.ws + WS_ROPEC); const float* qn = INP(22) + i * 96;
    GET_TID(wv);
    const int tid = tid_, lane = tid & 63, w = wv, r32 = lane & 31, h = lane >> 5, blk = (lane >> 4) & 1, q_ = (lane & 15) >> 2, p_ = lane & 3;
    constexpr int KB = 64 * 208, VB = 64 * 144, BUF = KB + VB;
    for (int uid = blockIdx.x; uid < 2048; uid += gridDim.x) {
        const int bh = (uid >> 8) * 8 + (uid & 7), qb = (uid >> 3) & 31, b = bh >> 3, head = bh & 7;
        const size_t tq = (size_t)b * SEQ + qb * 256 + w * 32 + r32;
        bf16x8 qf[6];
        {
            float qv[6][8]; float ss = 0.f;
#pragma unroll
            for (int s = 0; s < 6; ++s) { const u32x4 raw = *(const u32x4*)(QH + tq * 768 + head * 96 + 16 * s + 8 * h);
                qv[s][0] = bflo(raw.x); qv[s][1] = bfhi(raw.x); qv[s][2] = bflo(raw.y); qv[s][3] = bfhi(raw.y); qv[s][4] = bflo(raw.z); qv[s][5] = bfhi(raw.z); qv[s][6] = bflo(raw.w); qv[s][7] = bfhi(raw.w);
#pragma unroll
                for (int j = 0; j < 8; ++j) ss += qv[s][j] * qv[s][j]; }
            ss += shx(ss, 32);
            const float rs = 1.0f / sqrtf(ss * (1.0f / 96.0f) + EPS);
#pragma unroll
            for (int s = 0; s < 6; ++s)
#pragma unroll
                for (int j = 0; j < 8; ++j) qv[s][j] *= rs * qn[16 * s + 8 * h + j];
#pragma unroll
            for (int j = 0; j < 8; ++j) { const float c = ropeC[tq * 32 + 8 * h + j], sn = ropeC[tq * 32 + 16 + 8 * h + j]; const float lo = qv[4][j], hi = qv[5][j];
                qv[4][j] = lo * c - hi * sn; qv[5][j] = hi * c + lo * sn; }
            const float sc = 0.10206207261596577f * LOG2E;
#pragma unroll
            for (int s = 0; s < 6; ++s) { u32x4 pk; pk.x = cvtpk(qv[s][0] * sc, qv[s][1] * sc); pk.y = cvtpk(qv[s][2] * sc, qv[s][3] * sc); pk.z = cvtpk(qv[s][4] * sc, qv[s][5] * sc); pk.w = cvtpk(qv[s][6] * sc, qv[s][7] * sc); qf[s] = __builtin_bit_cast(bf16x8, pk); }
        }
        const bf16_t* Kg = KH + ((size_t)b * SEQ) * 768 + head * 96; const bf16_t* Vg = VH + ((size_t)b * SEQ) * 512 + head * 64;
        u32x4 kq[3], vq[2];
#define MLA_LD(t) do { const size_t ro_ = (size_t)(t) * 128; \
        _Pragma("unroll") for (int c_ = 0; c_ < 3; ++c_) { const int id_ = tid + 512 * c_; kq[c_] = *(const u32x4*)(Kg + (ro_ + id_ / 12) * 768 + (id_ % 12) * 8); } \
        _Pragma("unroll") for (int c_ = 0; c_ < 2; ++c_) { const int id_ = tid + 512 * c_; vq[c_] = *(const u32x4*)(Vg + (ro_ + (id_ >> 3)) * 512 + (id_ & 7) * 8); } } while (0)
#define MLA_ST(buf) do { LAS unsigned char* d_ = lds + (buf) * TB; \
        _Pragma("unroll") for (int c_ = 0; c_ < 3; ++c_) { const int id_ = tid + 512 * c_; *(LAS u32x4*)(d_ + (id_ / 12) * 208 + (id_ % 12) * 16) = kq[c_]; } \
        _Pragma("unroll") for (int c_ = 0; c_ < 2; ++c_) { const int id_ = tid + 512 * c_; *(LAS u32x4*)(d_ + KB2 + (id_ >> 3) * 144 + (id_ & 7) * 16) = vq[c_]; } } while (0)
        constexpr int KB2 = 128 * 208, VB2 = 128 * 144, TB = KB2 + VB2;
        float mrow = 0.f, l = 0.f; f32x16 o[2]; o[0] = zero16(); o[1] = zero16(); f32x16 negm = zero16();
        MLA_LD(0); MLA_ST(0);
        __syncthreads();
        for (int j = 0; j < 64; ++j) {
            LAS const unsigned char* kb_ = lds + (j & 1) * TB; LAS const unsigned char* vbp = kb_ + KB2;
            if (j + 1 < 64) MLA_LD(j + 1);
            f32x16 p[4];
#pragma unroll
            for (int kt = 0; kt < 4; ++kt) p[kt] = negm;
#pragma unroll
            for (int s = 0; s < 6; ++s)
#pragma unroll
                for (int kt = 0; kt < 4; ++kt) { const bf16x8 ka = *(LAS const bf16x8*)(kb_ + (32 * kt + r32) * 208 + 32 * s + 16 * h); p[kt] = MFMA32(ka, qf[s], p[kt]); }
            float mx = fmaxf(fmaxf(p[0][0], p[1][0]), fmaxf(p[2][0], p[3][0]));
#pragma unroll
            for (int rg = 1; rg < 16; ++rg) mx = fmaxf(mx, fmaxf(fmaxf(p[0][rg], p[1][rg]), fmaxf(p[2][rg], p[3][rg])));
            mx = fmaxf(mx, shx(mx, 32));
            if (__any(mx > 8.0f)) {
                const float dl = fmaxf(mx, 0.f), alpha = __builtin_amdgcn_exp2f(-dl); mrow += dl; l *= alpha;
#pragma unroll
                for (int rg = 0; rg < 16; ++rg) { p[0][rg] -= dl; p[1][rg] -= dl; p[2][rg] -= dl; p[3][rg] -= dl; o[0][rg] *= alpha; o[1][rg] *= alpha; negm[rg] = -mrow; }
            }
            float ls = 0.f;
#pragma unroll
            for (int kt = 0; kt < 4; ++kt)
#pragma unroll
                for (int rg = 0; rg < 16; ++rg) { p[kt][rg] = __builtin_amdgcn_exp2f(p[kt][rg]); ls += p[kt][rg]; }
            l += ls;
#pragma unroll
            for (int kt = 0; kt < 4; ++kt)
#pragma unroll
                for (int s = 0; s < 2; ++s) { const bf16x8 pb = pack8(p[kt], s);
#pragma unroll
                    for (int dt = 0; dt < 2; ++dt) { LAS const char* ad = (LAS const char*)vbp + (32 * kt + 16 * s + 4 * h + q_) * 144 + (32 * dt + 16 * blk) * 2 + 8 * p_;
                        const bf16x8 va = cat8(trread(ad), trread(ad + 8 * 144)); o[dt] = MFMA32(va, pb, o[dt]); } }
            if (j + 1 < 64) MLA_ST((j + 1) & 1);
            __syncthreads();
        }
#undef MLA_LD
#undef MLA_ST
        l += shx(l, 32); const float inv = 1.0f / l;
#pragma unroll
        for (int dt = 0; dt < 2; ++dt)
#pragma unroll
            for (int gq = 0; gq < 4; ++gq) { u32x2 ww; ww.x = cvtpk(o[dt][4 * gq] * inv, o[dt][4 * gq + 1] * inv); ww.y = cvtpk(o[dt][4 * gq + 2] * inv, o[dt][4 * gq + 3] * inv);
                *(u32x2*)(MG + tq * 768 + head * 64 + 32 * dt + 8 * gq + 4 * h) = ww; }
    }
}

__global__ void __launch_bounds__(512, 2) fnet_k(Args A, int which) {
    extern __shared__ __attribute__((aligned(16))) unsigned char lds_raw2[];
    LAS unsigned char* lds = (LAS unsigned char*)lds_raw2;
    const int wv = __builtin_amdgcn_readfirstlane(threadIdx.x >> 6);
    if (which == 1) fnet1_phase(A, lds, wv); else fnet2_phase(A, lds, A.pad, wv);
}
__global__ void __launch_bounds__(512, 2) fwd_mega(Args A) {
    extern __shared__ __attribute__((aligned(16))) unsigned char lds_raw[];
    LAS unsigned char* lds = (LAS unsigned char*)lds_raw;
    const int wv = __builtin_amdgcn_readfirstlane(threadIdx.x >> 6);
    if (A.ph_hi - A.ph_lo > 1) cg::this_grid().sync();
    unsigned* gctr = (unsigned*)(A.ws + 256); unsigned epoch = 0;
    int ph = 0; const int ph_lo = A.ph_lo, ph_hi = A.ph_hi;
#define RUN (ph >= ph_lo && ph < ph_hi)
#define SEAM() do { if (ph >= ph_lo && ph + 1 < ph_hi) gbar(gctr, epoch, wv); ++ph; } while (0)
    unsigned gepoch = 0; const bool grp_ok = (gridDim.x & 7) == 0;
#define SEAMG() do { if (ph >= ph_lo && ph + 1 < ph_hi) { if (grp_ok) gbar_grp(gctr + 256, gepoch, wv); else gbar(gctr, epoch, wv); } ++ph; } while (0)
    unsigned char* ws = A.ws;
    bf16_t* XB = (bf16_t*)(ws + WS_XB); float* SSQ = (float*)(ws + WS_SSQ); bf16_t* HID = (bf16_t*)(ws + WS_HID); bf16_t* MG = (bf16_t*)(ws + WS_MERGED);

    if ((PM & 1) && (A.rmask & 1) && RUN) p0_s5tab(A, lds, wv);
    __syncthreads();
    if ((PM & 2) && (A.rmask & 2) && RUN) p0_weights(A, lds, wv);
    if ((PM & 4) && (A.rmask & 4) && RUN) p0_rows(A, wv);
    if ((PM & 8) && (A.rmask & 8) && RUN) p0_fconst(A, wv);
    SEAM();
    if ((PM & 16) && (A.rmask & 16) && RUN) p0_s5mats(A, wv);
    SEAM();

    for (int layer = 0; layer < NLAYERS; ++layer) {
        for (int f = 0; f < 2; ++f) {
            int bid = blockIdx.x, G = gridDim.x; asm volatile("" : "+s"(bid), "+s"(G));
            asm volatile("" : "+s"(ws));
            if (f == 1) {
                const int i = layer >> 1;
                if ((layer & 1) == 0) {
                    const bf16_t* win = (const bf16_t*)(ws + WS_WEVEN + i * WEVEN_STRIDE); const bf16_t* wout = win + (size_t)1792 * 1024;
                    { pg8::Gemm g{XB, win, DM, DM, DM}; pg8::StaticOrder S; S.init(T, 1792, G, bid);
                      EpiEvenIn E{SSQ, INP(13) + i * 64, INP(14) + i * 64, (const float*)(ws + WS_ROPEA), (bf16_t*)(ws + WS_HID + EV_Q), (bf16_t*)(ws + WS_HID + EV_K), (bf16_t*)(ws + WS_HID + EV_V), (bf16_t*)(ws + WS_HID + EV_F)};
                      if ((PM & 32) && (A.rmask & 32) && RUN) pg8::gemm_phase(lds, g, S, E, wv); }
                    SEAMG();
                    if ((PM & 64) && (A.rmask & 64) && RUN) dilated_phase(A, lds, 0, wv);
                    if ((PM & 128) && (A.rmask & 128) && RUN) fnet1_phase(A, lds, wv);
                    SEAMG();
                    if ((PM & 64) && (A.rmask & 64) && RUN) dilated_phase(A, lds, 1, wv);
                    if ((PM & 256) && (A.rmask & 256) && RUN) fnet2_phase(A, lds, i, wv);
                    SEAMG();
                    if ((PM & 64) && (A.rmask & 64) && RUN) dilated_phase(A, lds, 2, wv);
                    SEAM();
                    { pg8::Gemm g{MG, wout, 768, 768, 768}; pg8::StaticOrder S; S.init(T, DM, G, bid);
                      EpiResid E{A.out, A.out, XB, SSQ, 1.0f}; if ((PM & 512) && (A.rmask & 512) && RUN) pg8::gemm_phase(lds, g, S, E, wv); }
                    SEAMG();
                } else {
                    unsigned char* wb = ws + WS_WODD + i * WODD_STRIDE2;
                    bf16_t* UA = (bf16_t*)(ws + WS_MIX2 + M2_UA); float* EB = (float*)(ws + WS_MIX2 + M2_EB); bf16_t* Z = (bf16_t*)(ws + WS_MIX2 + M2_Z);
                    { pg8::Gemm g{XB, (const bf16_t*)(wb + WO_IN), DM, DM, DM}; pg8::StaticOrder S; S.init(T, 768, G, bid);
                      EpiOddIn E{SSQ, (bf16_t*)(ws + WS_HID + OD_QLAT), (bf16_t*)(ws + WS_HID + OD_KVLAT), UA, (float*)(ws + WS_HID + OD_KPE), (float*)(ws + WS_HID + OD_SSQQ), (float*)(ws + WS_HID + OD_SSQKV), (float*)(ws + WS_HID + OD_SSPE)};
                      if ((PM & 1024) && (A.rmask & 1024) && RUN) pg8::gemm_phase(lds, g, S, E, wv); }
                    SEAM();
                    { pg8::Gemm g{UA, (const bf16_t*)(wb + WO_EMAT), 1280, 1024, 1024}; pg8::GroupOrder S{16, 4, 1, 4, 1, G, bid};
                      EpiE E{EB}; if ((PM & 2048) && (A.rmask & 2048) && RUN) pg8::gemm_phase(lds, g, S, E, wv); }
                    { pg8::Gemm g{(const bf16_t*)(ws + WS_HID + OD_QLAT), (const bf16_t*)(wb + WO_Q), 256, 256, 256}; pg8::StaticOrder S; S.init(T, 768, G, bid);
                      EpiQup E{(const float*)(ws + WS_HID + OD_SSQQ), (bf16_t*)(ws + WS_HID + OD_QH)}; if ((PM & 2048) && (A.rmask & 2048) && RUN) pg8::gemm_phase(lds, g, S, E, wv); }
                    { pg8::Gemm g{(const bf16_t*)(ws + WS_HID + OD_KVLAT), (const bf16_t*)(wb + WO_KV), 128, 128, 128}; pg8::StaticOrder S; S.init(T, 1024, G, bid);
                      EpiKVup E{(const float*)(ws + WS_HID + OD_SSQKV), (const float*)(ws + WS_HID + OD_SSPE), (const float*)(ws + WS_HID + OD_KPE), INP(23) + i * 96, (const float*)(ws + WS_ROPEC), (bf16_t*)(ws + WS_HID + OD_KH), (bf16_t*)(ws + WS_HID + OD_VH)};
                      if ((PM & 2048) && (A.rmask & 2048) && RUN) pg8::gemm_phase(lds, g, S, E, wv); }
                    SEAM();
                    if ((PM & 4096) && (A.rmask & 4096) && RUN) s5_scan(A, i, wv);
                    if ((PM & 8192) && (A.rmask & 8192) && RUN) mla_phase(A, lds, i, wv);
                    SEAM();
                    { pg8::Gemm g{UA, (const bf16_t*)(wb + WO_TMAT), 1280, 1280, 1280}; pg8::GroupOrder S{16, 4, 4, 4, 4, G, bid};
                      EpiY E{Z}; if ((PM & 16384) && (A.rmask & 16384) && RUN) pg8::gemm_phase(lds, g, S, E, wv); }
                    SEAM();
                    { pg8::Gemm g{Z, (const bf16_t*)(wb + WO_GLU), 256, 256, 256}; pg8::StaticOrder S; S.init(T, 256, G, bid);
                      EpiGLU E{Z, INP(33) + i * 256, MG}; if ((PM & 32768) && (A.rmask & 32768) && RUN) pg8::gemm_phase(lds, g, S, E, wv); }
                    SEAM();
                    { pg8::Gemm g{MG, (const bf16_t*)(wb + WO_OUT), 768, 768, 768}; pg8::StaticOrder S; S.init(T, DM, G, bid);
                      EpiResid E{A.out, A.out, XB, SSQ, 1.0f}; if ((PM & 512) && (A.rmask & 512) && RUN) pg8::gemm_phase(lds, g, S, E, wv); }
                    SEAMG();
                }
            }
            const int lf = layer * 2 + f;
            const bf16_t* gu = (const bf16_t*)(ws + WS_WFFN + lf * WFFN_STRIDE); const bf16_t* dn = gu + (size_t)5632 * 1024;
            { pg8::Gemm g{XB, gu, DM, DM, DM}; pg8::StaticOrder S; S.init(T, 5632, G, bid);
              EpiSwiglu E{SSQ, HID}; if ((PM & 65536) && (A.rmask & 65536) && RUN) pg8::gemm_phase(lds, g, S, E, wv); }
            SEAMG();
            { pg8::Gemm g{HID, dn, FF, FF, FF}; pg8::StaticOrder S; S.init(T, DM, G, bid);
              EpiResid E{(layer == 0 && f == 0) ? INP(0) : A.out, A.out, XB, SSQ, 0.5f}; if ((PM & 512) && (A.rmask & 512) && RUN) pg8::gemm_phase(lds, g, S, E, wv); }
            if (f == 1) SEAMG(); else SEAM();
        }
    }
}

extern "C" void kernel_launch(void* const* d_in, const int* in_sizes, int n_in, void* d_out, int out_size, void* d_ws, size_t ws_size, hipStream_t stream) {
    static int grid = 0;
    if (grid == 0) {
        int dev = 0, cus = 0, per_cu = 0;
        hipGetDevice(&dev); hipDeviceGetAttribute(&cus, hipDeviceAttributeMultiprocessorCount, dev);
        hipFuncSetAttribute((const void*)fwd_mega, hipFuncAttributeMaxDynamicSharedMemorySize, LDS_BYTES);
        hipOccupancyMaxActiveBlocksPerMultiprocessor(&per_cu, (const void*)fwd_mega, 512, LDS_BYTES);
        if (per_cu < 1) per_cu = 1;
        grid = cus * 1;
        if (n_in != 34 || ws_size < WS_END) fprintf(stderr, "kernel_launch: unexpected n_in %d / ws %zu\n", n_in, ws_size);
    }
    hipMemsetAsync(d_ws, 0, 4096, stream);
    Args a{};
    for (int i = 0; i < 34; ++i) a.in[i] = (const float*)d_in[i];
    a.out = (float*)d_out; a.ws = (unsigned char*)d_ws;
    constexpr int NPH = 40; a.rmask = RMASK;
#if MULTI == 1
    for (int ph = 0; ph < NPH; ++ph) { a.ph_lo = ph; a.ph_hi = ph + 1; hipLaunchKernelGGL(fwd_mega, dim3(grid), dim3(512), LDS_BYTES, stream, a); }
#elif MULTI == 2
    {
        static bool once = false; if (!once) { hipFuncSetAttribute((const void*)fnet_k, hipFuncAttributeMaxDynamicSharedMemorySize, LDS_BYTES); once = true; }
        const int seg[4] = {0, 7, 28, NPH}; a.rmask = RMASK & ~384;
        for (int sgi = 0; sgi < 3; ++sgi) {
            Args b = a; b.ph_lo = seg[sgi]; b.ph_hi = sgi < 2 ? seg[sgi + 1] - 2 : seg[sgi + 1];
            void* args[] = {&b};
            hipError_t e = hipLaunchCooperativeKernel((const void*)fwd_mega, dim3(grid), dim3(512), args, LDS_BYTES, stream);
            if (e != hipSuccess) fprintf(stderr, "cooperative launch failed: %s (grid %d)\n", hipGetErrorString(e), grid);
            if (sgi < 2) { Args c = a; c.pad = sgi; c.ph_lo = 0; c.ph_hi = 1;
                hipLaunchKernelGGL(fnet_k, dim3(grid), dim3(512), LDS_BYTES, stream, c, 1);
                hipLaunchKernelGGL(fnet_k, dim3(grid), dim3(512), LDS_BYTES, stream, c, 2); }
        }
    }
#else
    a.ph_lo = 0; a.ph_hi = NPH;
    void* args[] = {&a};
    hipError_t e = hipLaunchCooperativeKernel((const void*)fwd_mega, dim3(grid), dim3(512), args, LDS_BYTES, stream);
    if (e != hipSuccess) fprintf(stderr, "cooperative launch failed: %s (grid %d)\n", hipGetErrorString(e), grid);
#endif

}
```

```cpp
#include <hip/hip_runtime.h>
#include <hip/hip_cooperative_groups.h>
#include <cstdint>
#include <cstdio>
namespace cg = cooperative_groups;

#define DI __device__ __forceinline__
#define LAS __attribute__((address_space(3)))
typedef unsigned short bf16_t;
typedef short bf16x8 __attribute__((ext_vector_type(8)));
typedef short s16x4 __attribute__((ext_vector_type(4)));
typedef float f32x2 __attribute__((ext_vector_type(2)));
typedef float f32x4 __attribute__((ext_vector_type(4)));
typedef float f32x16 __attribute__((ext_vector_type(16)));
typedef unsigned u32x2 __attribute__((ext_vector_type(2)));
typedef unsigned u32x4 __attribute__((ext_vector_type(4)));

constexpr int NB = 8, SEQ = 8192, T = NB * SEQ, DM = 1024, FF = 2816, DEPTH = 4;
constexpr float EPS = 1e-6f;
constexpr float LOG2E = 1.4426950408889634f;

constexpr size_t MiB = 1u << 20;
constexpr size_t WS_WFFN = 1 * MiB;
constexpr size_t WFFN_STRIDE = 16 * MiB + MiB / 2;
constexpr size_t WS_WEVEN = WS_WFFN + 8 * WFFN_STRIDE;
constexpr size_t WEVEN_STRIDE = 5 * MiB;
constexpr size_t WS_WODD = WS_WEVEN + 2 * WEVEN_STRIDE;
constexpr size_t WODD_STRIDE = 52 * MiB;
constexpr size_t WO_IN = 0, WO_Q = 1 * MiB + MiB / 2, WO_KV = 2 * MiB, WO_OUT = 2 * MiB + MiB / 2, WO_GLU = 4 * MiB, WO_EMAT = 4 * MiB + MiB / 2  , WO_TMAT = 12 * MiB + MiB / 2  ;
constexpr size_t WODD_STRIDE2 = 53 * MiB;
constexpr size_t WS_FCONST = WS_WODD + 2 * WODD_STRIDE2;
constexpr size_t FC_D128C = 0, FC_D128NS = 32768, FC_D64C = 65536, FC_D64S = 65536 + 8192, FC_D64NS = 65536 + 16384, FC_TW = 131072  , FC_PT = 262144  , FC_QT = 262144 + 65536;
constexpr size_t WS_S5TAB = WS_FCONST + 1 * MiB;
constexpr size_t S5_KTAB = 0, S5_LP = 4 * MiB, S5_BB = 7 * MiB;
constexpr size_t WS_ROPEA = WS_S5TAB + 8 * MiB;
constexpr size_t WS_ROPEC = WS_ROPEA + 4 * MiB;
constexpr size_t WS_XB = WS_ROPEC + 8 * MiB;
constexpr size_t WS_SSQ = WS_XB + 128 * MiB;
constexpr size_t WS_HID = WS_SSQ + 4 * MiB;
constexpr size_t WS_MERGED = WS_HID + 352 * MiB;
constexpr size_t WS_MIX2 = WS_MERGED + 96 * MiB;
constexpr size_t WS_END = WS_MIX2 + 92 * MiB;
constexpr size_t EV_Q = 0, EV_K = 64 * MiB, EV_V = 128 * MiB, EV_F = 192 * MiB, EV_YP = 224 * MiB;
constexpr size_t OD_TAIL = (WS_END - WS_HID);
constexpr size_t OD_QLAT = OD_TAIL + 0, OD_KVLAT = OD_TAIL + 32 * MiB, OD_KPE = OD_TAIL + 48 * MiB, OD_SSQQ = OD_TAIL + 56 * MiB, OD_SSQKV = OD_TAIL + 57 * MiB, OD_SSPE = OD_TAIL + 58 * MiB, OD_QH = 60 * MiB, OD_KH = 156 * MiB, OD_VH = 252 * MiB;
constexpr size_t M2_UA = 0  , M2_EB = 40 * MiB  , M2_Z = 56 * MiB  , M2_LSE = 88 * MiB  ;

constexpr int LDS_BYTES = 147456;
#ifndef RMASK
#define RMASK 0xFFFFF
#endif
#ifndef MULTI
#define MULTI 0
#endif
#ifndef NOSTORE
#define NOSTORE 0
#endif
#ifndef LDSCLEAR
#define LDSCLEAR 0
#endif
#ifndef ZMODE
#define ZMODE 0
#endif
#ifndef NLAYERS
#define NLAYERS DEPTH
#endif
#ifndef PM
#define PM 0xFFFFF
#endif

DI const float* INP(int k) { auto p = __builtin_amdgcn_kernarg_segment_ptr(); asm volatile("" : "+s"(p));
    typedef const float* cfp; return ((__attribute__((address_space(4))) const cfp*)p)[k]; }
DI int lane_id() { int l; asm volatile("v_mbcnt_lo_u32_b32 %0, -1, 0\n\tv_mbcnt_hi_u32_b32 %0, -1, %0" : "=v"(l)); return l; }
DI float shx(float v, int mask) { const int l = lane_id(); return __int_as_float(__builtin_amdgcn_ds_bpermute((l ^ mask) << 2, __float_as_int(v))); }
#define GET_TID(wv) int tid_ = (wv) * 64 + lane_id(); asm volatile("" : "+v"(tid_))
#ifdef USE_CG_SYNC
DI void gbar(unsigned* ctr, unsigned& epoch, int wv) {
    asm volatile("s_waitcnt vmcnt(0) lgkmcnt(0)" ::: "memory");
    __builtin_amdgcn_fence(__ATOMIC_RELEASE, "agent");
    asm volatile("s_waitcnt vmcnt(0)" ::: "memory");
    cg::this_grid().sync();
    __builtin_amdgcn_fence(__ATOMIC_ACQUIRE, "agent");
    asm volatile("s_waitcnt vmcnt(0)" ::: "memory");
    __syncthreads(); }
#else
DI void gbar(unsigned* ctr, unsigned& epoch, int wv) {
    asm volatile("s_waitcnt vmcnt(0) lgkmcnt(0)" ::: "memory");
    __syncthreads();
    ++epoch;
    unsigned target = epoch * gridDim.x; asm volatile("" : "+s"(target));
    if (wv == 0 && lane_id() == 0) {
        __builtin_amdgcn_fence(__ATOMIC_RELEASE, "agent");
        asm volatile("s_waitcnt vmcnt(0)" ::: "memory");
        __hip_atomic_fetch_add(ctr, 1u, __ATOMIC_RELAXED, __HIP_MEMORY_SCOPE_AGENT);
        while (__hip_atomic_load(ctr, __ATOMIC_RELAXED, __HIP_MEMORY_SCOPE_AGENT) < target) __builtin_amdgcn_s_sleep(2);
        __builtin_amdgcn_fence(__ATOMIC_ACQUIRE, "agent");
        asm volatile("s_waitcnt vmcnt(0)" ::: "memory");
    }
    __syncthreads();
}
#endif
DI void gbar_grp(unsigned* ctr0, unsigned& gepoch, int wv) {
    asm volatile("s_waitcnt vmcnt(0) lgkmcnt(0)" ::: "memory");
    __syncthreads();
    ++gepoch;
    unsigned target = gepoch * (gridDim.x >> 3); asm volatile("" : "+s"(target));
    if (wv == 0 && lane_id() == 0) {
        unsigned* ctr = ctr0 + 64 * (blockIdx.x & 7);
        __builtin_amdgcn_fence(__ATOMIC_RELEASE, "agent");
        asm volatile("s_waitcnt vmcnt(0)" ::: "memory");
        __hip_atomic_fetch_add(ctr, 1u, __ATOMIC_RELAXED, __HIP_MEMORY_SCOPE_AGENT);
        while (__hip_atomic_load(ctr, __ATOMIC_RELAXED, __HIP_MEMORY_SCOPE_AGENT) < target) __builtin_amdgcn_s_sleep(2);
        __builtin_amdgcn_fence(__ATOMIC_ACQUIRE, "agent");
        asm volatile("s_waitcnt vmcnt(0)" ::: "memory");
    }
    __syncthreads();
}
DI unsigned cvtpk(float lo, float hi) { typedef __bf16 b2 __attribute__((ext_vector_type(2))); f32x2 v = {lo, hi}; b2 b = __builtin_convertvector(v, b2); return __builtin_bit_cast(unsigned, b); }
DI float bf2f(unsigned v) { return __uint_as_float(v << 16); }
DI float bflo(unsigned v) { return __uint_as_float(v << 16); }
DI float bfhi(unsigned v) { return __uint_as_float(v & 0xffff0000u); }
DI int crow(int reg, int h) { return (reg & 3) + 8 * (reg >> 2) + 4 * h; }
#define MFMA32(a, b, c) __builtin_amdgcn_mfma_f32_32x32x16_bf16((a), (b), (c), 0, 0, 0)
typedef short v4i16_t __attribute__((ext_vector_type(4)));
DI s16x4 trread(LAS const char* p) { return __builtin_bit_cast(s16x4, __builtin_amdgcn_ds_read_tr16_b64_v4i16((LAS v4i16_t*)p)); }
DI bf16x8 cat8(s16x4 lo, s16x4 hi) { return __builtin_shufflevector(lo, hi, 0, 1, 2, 3, 4, 5, 6, 7); }
DI bf16x8 pack8(const f32x16& x, int s) {
    u32x4 p; p.x = cvtpk(x[8 * s], x[8 * s + 1]); p.y = cvtpk(x[8 * s + 2], x[8 * s + 3]); p.z = cvtpk(x[8 * s + 4], x[8 * s + 5]); p.w = cvtpk(x[8 * s + 6], x[8 * s + 7]);
    return __builtin_bit_cast(bf16x8, p);
}
DI f32x16 zero16() { f32x16 z; for (int i = 0; i < 16; ++i) z[i] = 0.f; return z; }
DI f32x16 zero16p() { f32x16 z; for (int i = 0; i < 16; ++i) z[i] = 0.f; asm volatile("" : "+v"(z)); return z; }

namespace pg8 {
constexpr int BM = 256, BK = 64, HALF = 128, HTB = HALF * BK * 2, STAGE_BYTES = 8 * HTB, NXCD = 8, WGM = 8;
__host__ __device__ __forceinline__ int lds_byte(int r, int c) { const int st = (r >> 4) * 2 + (c >> 5), rr = r & 15, cc = c & 31, ob = rr * 64 + cc * 2; return st * 1024 + (ob ^ (((ob >> 9) & 1) << 5)); }
__host__ __device__ __forceinline__ void stage_rc(int b, int& R, int& C) { const int st = b / 1024, sb = b % 1024, swz = sb ^ (((sb >> 9) & 1) << 5); R = (st >> 1) * 16 + swz / 64; C = (st & 1) * 32 + (swz % 64) / 2; }
__host__ __device__ __forceinline__ int perm32(int rho) { const int n = rho >> 4, i = rho & 15; return 8 * (i >> 2) + 4 * n + (i & 3); }
struct Unit { int pm, pn; };
struct Gemm { const bf16_t* A; const bf16_t* Bt; int lda, ldb, K; };
struct StaticOrder {
    int nM, nN, nwg, G, c;
    __device__ void init(int M, int N, int G_, int c_) { nM = M / BM; nN = N / BM; nwg = nM * nN; G = G_; c = c_; }
    __device__ bool next(int i, Unit& u) const {
        const long L = (long)i * G + c; if (L >= nwg) return false;
        int wgid = (int)L; { const int q = nwg / NXCD, r = nwg % NXCD, xcd = wgid % NXCD, off = wgid / NXCD; wgid = (xcd < r ? xcd * (q + 1) : r * (q + 1) + (xcd - r) * q) + off; }
        const int nig = WGM * nN, gid = wgid / nig, fm = gid * WGM, gsz = (nM - fm) < WGM ? (nM - fm) : WGM;
        u.pm = fm + ((wgid % nig) % gsz); u.pn = (wgid % nig) / gsz; return true;
    }
};
struct GroupOrder {
    int ng, nm, nn, pms, pns, G, c;
    __device__ bool next(int i, Unit& u) const {
        const long L = (long)i * G + c; const int tot = ng * nm * nn; if (L >= tot) return false;
        const int id = (int)L, g = id / (nm * nn), r = id % (nm * nn); u.pm = g * pms + r % nm; u.pn = g * pns + r / nm; return true;
    }
};

template <class Epi, class Sched>
__device__ __forceinline__ void gemm_phase(LAS unsigned char* lds, const Gemm g, const Sched& S, const Epi& E, const int wid_in) {
    int wid = wid_in; asm volatile("" : "+s"(wid));
    const int wr = wid >> 2, wc = wid & 3;
    if (LDSCLEAR) { GET_TID(wid); const u32x4 z4 = {0u, 0u, 0u, 0u};
        for (int o = tid_ * 16; o < STAGE_BYTES; o += 8192) *(LAS u32x4*)(lds + o) = z4;
        asm volatile("s_waitcnt lgkmcnt(0)" ::: "memory"); __syncthreads(); }
    const int K = g.K, nt = K / BK;
    const char* gA = (const char*)g.A; const char* gB = (const char*)g.Bt;
    asm volatile("" : "+s"(gA), "+s"(gB));
    unsigned voffA[2], voffB[2]; int aoff, boff;
#define PG8_IDS() do { GET_TID(wid); const int l_ = tid_ & 63; \
        _Pragma("unroll") for (int i = 0; i < 2; ++i) { int R, C; stage_rc(tid_ * 16 + i * 8192, R, C); const int Rb = (R & ~31) + perm32(R & 31); \
            voffA[i] = (unsigned)(R * g.lda + C) * 2u; voffB[i] = (unsigned)(Rb * g.ldb + C) * 2u; } \
        aoff = lds_byte(wr * 64 + (l_ & 15), (l_ >> 4) * 8); boff = lds_byte(wc * 32 + (l_ & 15), (l_ >> 4) * 8); } while (0)
    PG8_IDS();
    const size_t kstep = (size_t)(BK * 2);
    const size_t hstepA = (size_t)HALF * g.lda * 2, hstepB = (size_t)HALF * g.ldb * 2;
    const size_t tstepA = 2 * hstepA, tstepB = 2 * hstepB;
    const unsigned ldsw = (unsigned)wid * 1024u;
#define PG8_SA(b, h) (((b) * 2 + (h)) * HTB)
#define PG8_SB(b, h) ((4 + (b) * 2 + (h)) * HTB)
#define PG8_STAGE(bufoff, gbase, voff) do { _Pragma("unroll") for (int _i = 0; _i < 2; ++_i) \
        __builtin_amdgcn_global_load_lds((const unsigned*)((const char*)(gbase) + (voff)[_i]), (LAS unsigned*)(lds + (bufoff) + ldsw + _i * 8192), 16, 0, 0); } while (0)
#define PG8_LDA(dst, b, h) do { _Pragma("unroll") for (int m = 0; m < 4; ++m) _Pragma("unroll") for (int k = 0; k < 2; ++k) dst[m][k] = *(const LAS bf16x8*)(lds + PG8_SA(b, h) + aoff + m * 2048 + k * 1024); } while (0)
#define PG8_LDB(dst, b, h) do { _Pragma("unroll") for (int n = 0; n < 2; ++n) _Pragma("unroll") for (int k = 0; k < 2; ++k) dst[n][k] = *(const LAS bf16x8*)(lds + PG8_SB(b, h) + boff + n * 2048 + k * 1024); } while (0)
#define PG8_MMA(ai, bj, At, Bt) do { __builtin_amdgcn_s_setprio(1); _Pragma("unroll") for (int m = 0; m < 4; ++m) _Pragma("unroll") for (int n = 0; n < 2; ++n) _Pragma("unroll") for (int k = 0; k < 2; ++k) \
        acc[ai][bj][m][n] = __builtin_amdgcn_mfma_f32_16x16x32_bf16(Bt[n][k], At[m][k], acc[ai][bj][m][n], 0, 0, 0); __builtin_amdgcn_s_setprio(0); } while (0)
#define PG8_WAIT_V(n) asm volatile("s_waitcnt vmcnt(" #n ")" ::: "memory")
#define PG8_WAIT_L(n) asm volatile("s_waitcnt lgkmcnt(" #n ")" ::: "memory")
#define PG8_BAR __builtin_amdgcn_s_barrier()
#define PG8_SCHED __builtin_amdgcn_sched_barrier(0)
    Unit cur, nxt; int ui = 0;
    if (!S.next(0, cur)) return;
    f32x4 acc[2][2][4][2];
#pragma unroll
    for (int a = 0; a < 2; ++a)
#pragma unroll
        for (int b = 0; b < 2; ++b)
#pragma unroll
            for (int m = 0; m < 4; ++m)
#pragma unroll
                for (int n = 0; n < 2; ++n) acc[a][b][m][n] = (f32x4){0.f, 0.f, 0.f, 0.f};
    bf16x8 At[4][2], B0[2][2], B1[2][2];
    const char* cA = gA + (size_t)cur.pm * tstepA; const char* cB = gB + (size_t)cur.pn * tstepB;
    PG8_STAGE(PG8_SB(0, 0), cB, voffB); PG8_STAGE(PG8_SB(0, 1), cB + hstepB, voffB); PG8_STAGE(PG8_SA(0, 0), cA, voffA); PG8_STAGE(PG8_SA(0, 1), cA + hstepA, voffA);
    if (wr == 1) PG8_BAR;
    PG8_WAIT_V(2); PG8_BAR;
    PG8_STAGE(PG8_SB(1, 0), cB + kstep, voffB); PG8_STAGE(PG8_SA(1, 0), cA + kstep, voffA); PG8_STAGE(PG8_SB(1, 1), cB + hstepB + kstep, voffB);
    PG8_WAIT_V(6); PG8_BAR;
    for (;;) {
        const bool has_next = S.next(ui + 1, nxt);
        const char* nA = has_next ? gA + (size_t)nxt.pm * tstepA : cA; const char* nB = has_next ? gB + (size_t)nxt.pn * tstepB : cB;
        for (int t = 0; t < nt; t += 2) {
            const bool last = (t == nt - 2);
            const char* a1 = cA + (size_t)(t + 1) * kstep;
            const char* a2 = last ? nA : cA + (size_t)(t + 2) * kstep; const char* b2 = last ? nB : cB + (size_t)(t + 2) * kstep;
            const char* a3 = a2 + kstep; const char* b3 = b2 + kstep;
            PG8_LDB(B0, 0, 0); PG8_LDB(B1, 0, 1); PG8_SCHED; PG8_LDA(At, 0, 0); PG8_STAGE(PG8_SA(1, 1), a1 + hstepA, voffA);
            PG8_WAIT_V(8); PG8_WAIT_L(0); PG8_BAR; PG8_MMA(0, 0, At, B0); PG8_MMA(0, 1, At, B1); PG8_BAR; PG8_SCHED;
            PG8_LDA(At, 0, 1); PG8_STAGE(PG8_SB(0, 0), b2, voffB); PG8_STAGE(PG8_SB(0, 1), b2 + hstepB, voffB); PG8_STAGE(PG8_SA(0, 0), a2, voffA);
            PG8_WAIT_V(8); PG8_WAIT_L(0); PG8_BAR; PG8_MMA(1, 0, At, B0); PG8_MMA(1, 1, At, B1); PG8_BAR; PG8_SCHED;
            PG8_LDB(B0, 1, 0); PG8_LDB(B1, 1, 1); PG8_SCHED; PG8_LDA(At, 1, 0); PG8_STAGE(PG8_SA(0, 1), a2 + hstepA, voffA);
            PG8_WAIT_V(8); PG8_WAIT_L(0); PG8_BAR; PG8_MMA(0, 0, At, B0); PG8_MMA(0, 1, At, B1); PG8_BAR; PG8_SCHED;
            PG8_LDA(At, 1, 1); PG8_STAGE(PG8_SB(1, 0), b3, voffB); PG8_STAGE(PG8_SB(1, 1), b3 + hstepB, voffB); PG8_STAGE(PG8_SA(1, 0), a3, voffA);
            PG8_WAIT_V(8); PG8_WAIT_L(0); PG8_BAR; PG8_MMA(1, 0, At, B0); PG8_MMA(1, 1, At, B1); PG8_BAR; PG8_SCHED;
        }
        if (wr == 0) PG8_BAR;
        { GET_TID(wid); const int l_ = tid_ & 63; E(acc, cur, wr, wc, l_ & 15, l_ >> 4); }
        if (!has_next) break;
        PG8_IDS();
#pragma unroll
        for (int a = 0; a < 2; ++a)
#pragma unroll
            for (int b = 0; b < 2; ++b)
#pragma unroll
                for (int m = 0; m < 4; ++m)
#pragma unroll
                    for (int n = 0; n < 2; ++n) acc[a][b][m][n] = (f32x4){0.f, 0.f, 0.f, 0.f};
        cur = nxt; cA = nA; cB = nB; ++ui;
        if (wr == 1) PG8_BAR;
    }
    PG8_WAIT_V(0);
    PG8_BAR;
#undef PG8_IDS
#undef PG8_SA
#undef PG8_SB
#undef PG8_STAGE
#undef PG8_LDA
#undef PG8_LDB
#undef PG8_MMA
#undef PG8_WAIT_V
#undef PG8_WAIT_L
#undef PG8_BAR
#undef PG8_SCHED
}
}
using pg8::Unit;
typedef const f32x4 (&AccRef)[2][2][4][2];

#define EFENCE() asm volatile("" ::: "memory")
#define EROW(u, ai, m) ((u).pm * 256 + (ai) * 128 + wr * 64 + (m) * 16 + fr)
DI float rstd16(const float* ssq, int row, int fq) {
    const f32x4 v = *(const f32x4*)(ssq + (size_t)row * 16 + fq * 4);
    float s = (v.x + v.y) + (v.z + v.w); s += shx(s, 16); s += shx(s, 32);
    return __builtin_amdgcn_rsqf(s * (1.0f / 1024.0f) + EPS);
}
DI float sum4q(float s) { s += shx(s, 16); s += shx(s, 32); return s; }
DI float sq4(const f32x4& v) { return (v.x * v.x + v.y * v.y) + (v.z * v.z + v.w * v.w); }
DI u32x4 pk8(const f32x4& a, const f32x4& b) { u32x4 w; w.x = cvtpk(a.x, a.y); w.y = cvtpk(a.z, a.w); w.z = cvtpk(b.x, b.y); w.w = cvtpk(b.z, b.w); return w; }

struct EpiSwiglu {
    const float* ssq; bf16_t* hid;
    DI void operator()(AccRef acc, const Unit& u, int wr, int wc, int fr, int fq) const {
        float rsv[2][4];
#pragma unroll
        for (int ai = 0; ai < 2; ++ai)
#pragma unroll
            for (int m = 0; m < 4; ++m) rsv[ai][m] = rstd16(ssq, EROW(u, ai, m), fq);
#pragma unroll
        for (int ai = 0; ai < 2; ++ai)
#pragma unroll
            for (int m = 0; m < 4; ++m) { EFENCE();
                const int row = EROW(u, ai, m); const float rs = rsv[ai][m];
                f32x4 o[2];
#pragma unroll
                for (int n = 0; n < 2; ++n) { const f32x4 g = acc[ai][0][m][n] * rs, v = acc[ai][1][m][n] * rs;
#pragma unroll
                    for (int k = 0; k < 4; ++k) o[n][k] = g[k] * __builtin_amdgcn_rcpf(1.0f + __builtin_amdgcn_exp2f(-LOG2E * g[k])) * v[k]; }
                *(u32x4*)(hid + (size_t)row * FF + u.pn * 128 + wc * 32 + 8 * fq) = pk8(o[0], o[1]);
            }
    }
};
struct EpiResid {
    const float* xin; float* xout; bf16_t* xb; float* ssq; float alpha;
    DI void operator()(AccRef acc, const Unit& u, int wr, int wc, int fr, int fq) const {
#pragma unroll
        for (int ai = 0; ai < 2; ++ai)
#pragma unroll
            for (int m = 0; m < 4; ++m) { if ((m & 1) == 0) EFENCE();
                const int row = EROW(u, ai, m); float ss = 0.f;
#pragma unroll
                for (int bj = 0; bj < 2; ++bj) {
                    const size_t off = (size_t)row * DM + u.pn * 256 + bj * 128 + wc * 32 + 8 * fq;
                    f32x4 x0 = *(const f32x4*)(xin + off), x1 = *(const f32x4*)(xin + off + 4);
                    x0 += acc[ai][bj][m][0] * alpha; x1 += acc[ai][bj][m][1] * alpha;
                    *(f32x4*)(xout + off) = x0; *(f32x4*)(xout + off + 4) = x1;
                    *(u32x4*)(xb + off) = pk8(x0, x1); ss += sq4(x0) + sq4(x1);
                }
                ss = sum4q(ss);
                if (fq == 0) ssq[(size_t)row * 16 + u.pn * 4 + wc] = ss;
            }
    }
};
struct EpiEvenIn {
    const float* ssq; const float* qn; const float* kn; const float* ropeA; bf16_t *Q, *K, *V, *F;
    DI void operator()(AccRef acc, const Unit& u, int wr, int wc, int fr, int fq) const {
        const int kind = u.pn >> 1;
        float rsv[2][4];
#pragma unroll
        for (int ai = 0; ai < 2; ++ai)
#pragma unroll
            for (int m = 0; m < 4; ++m) rsv[ai][m] = rstd16(ssq, EROW(u, ai, m), fq);
#pragma unroll
        for (int ai = 0; ai < 2; ++ai)
#pragma unroll
            for (int m = 0; m < 4; ++m) { EFENCE();
                const int row = EROW(u, ai, m); const float rs = rsv[ai][m];
                f32x4 v[2][2];
#pragma unroll
                for (int bj = 0; bj < 2; ++bj)
#pragma unroll
                    for (int n = 0; n < 2; ++n) v[bj][n] = acc[ai][bj][m][n] * rs;
                if (u.pn == 6) {
#pragma unroll
                    for (int bj = 0; bj < 2; ++bj) *(u32x4*)(F + (size_t)row * 256 + bj * 128 + wc * 32 + 8 * fq) = pk8(v[bj][0], v[bj][1]);
                } else {
                    const int head = 4 * (u.pn & 1) + wc;
                    if (kind < 2) {
                        float ss = sq4(v[0][0]) + sq4(v[0][1]) + sq4(v[1][0]) + sq4(v[1][1]); ss = sum4q(ss);
                        const float hr = 1.0f / sqrtf(ss * (1.0f / 64.0f) + EPS);
                        const float* gn = kind == 0 ? qn : kn;
#pragma unroll
                        for (int bj = 0; bj < 2; ++bj)
#pragma unroll
                            for (int n = 0; n < 2; ++n) { const f32x4 gv = *(const f32x4*)(gn + 32 * bj + 8 * fq + 4 * n); v[bj][n] = v[bj][n] * hr * gv; }
                        f32x4 pr[2];
#pragma unroll
                        for (int n = 0; n < 2; ++n)
#pragma unroll
                            for (int k = 0; k < 4; ++k) pr[n][k] = shx(v[0][n][k], 16);
                        if (fq < 2) {
                            const float* rp = ropeA + (size_t)row * 16;
#pragma unroll
                            for (int n = 0; n < 2; ++n) { const f32x4 c = *(const f32x4*)(rp + 4 * n), s = *(const f32x4*)(rp + 8 + 4 * n);
                                v[0][n] = fq == 0 ? (v[0][n] * c - pr[n] * s) : (v[0][n] * c + pr[n] * s); }
                        }
                        if (kind == 0) {
#pragma unroll
                            for (int bj = 0; bj < 2; ++bj)
#pragma unroll
                                for (int n = 0; n < 2; ++n) v[bj][n] = v[bj][n] * (0.125f * LOG2E);
                        }
                    }
                    bf16_t* dst = Q + (size_t)kind * (32u << 20);
#pragma unroll
                    for (int bj = 0; bj < 2; ++bj) *(u32x4*)(dst + (size_t)row * 512 + head * 64 + 32 * bj + 8 * fq) = pk8(v[bj][0], v[bj][1]);
                }
            }
    }
};
struct EpiOddIn {
    const float* ssq; bf16_t *QLAT, *KVLAT, *UA; float *KPE, *SSQQ, *SSQKV, *SSPE;
    DI void operator()(AccRef acc, const Unit& u, int wr, int wc, int fr, int fq) const {
        float rsv[2][4];
#pragma unroll
        for (int ai = 0; ai < 2; ++ai)
#pragma unroll
            for (int m = 0; m < 4; ++m) rsv[ai][m] = rstd16(ssq, EROW(u, ai, m), fq);
#pragma unroll
        for (int ai = 0; ai < 2; ++ai)
#pragma unroll
            for (int m = 0; m < 4; ++m) { EFENCE();
                const int row = EROW(u, ai, m); const float rs = rsv[ai][m];
                f32x4 v[2][2];
#pragma unroll
                for (int bj = 0; bj < 2; ++bj)
#pragma unroll
                    for (int n = 0; n < 2; ++n) v[bj][n] = acc[ai][bj][m][n] * rs;
                if (u.pn == 0) {
                    float ss = sq4(v[0][0]) + sq4(v[0][1]) + sq4(v[1][0]) + sq4(v[1][1]); ss = sum4q(ss);
#pragma unroll
                    for (int bj = 0; bj < 2; ++bj) *(u32x4*)(QLAT + (size_t)row * 256 + bj * 128 + wc * 32 + 8 * fq) = pk8(v[bj][0], v[bj][1]);
                    if (fq == 0) SSQQ[(size_t)row * 4 + wc] = ss;
                } else if (u.pn == 1) {
                    float ss = sq4(v[0][0]) + sq4(v[0][1]); ss = sum4q(ss);
                    float sp = sq4(v[1][0]) + sq4(v[1][1]); sp = sum4q(sp);
                    *(u32x4*)(KVLAT + (size_t)row * 128 + wc * 32 + 8 * fq) = pk8(v[0][0], v[0][1]);
                    if (fq == 0) SSQKV[(size_t)row * 4 + wc] = ss;
                    if (wc == 0) { *(f32x4*)(KPE + (size_t)row * 32 + 8 * fq) = v[1][0]; *(f32x4*)(KPE + (size_t)row * 32 + 8 * fq + 4) = v[1][1]; if (fq == 0) SSPE[row] = sp; }
                } else {
                    const int chunk = row >> 6, s = row & 63;
#pragma unroll
                    for (int bj = 0; bj < 2; ++bj) { const int g = 8 * bj + 2 * wc + (fq >> 1), h0 = 8 * (fq & 1);
                        *(u32x4*)(UA + ((size_t)g * 1024 + chunk) * 1280 + s * 16 + h0) = pk8(v[bj][0], v[bj][1]); }
                }
            }
    }
};
struct EpiQup {
    const float* SSQQ; bf16_t* QH;
    DI void operator()(AccRef acc, const Unit& u, int wr, int wc, int fr, int fq) const {
#pragma unroll
        for (int ai = 0; ai < 2; ++ai)
#pragma unroll
            for (int m = 0; m < 4; ++m) { EFENCE();
                const int row = EROW(u, ai, m); const f32x4 p = *(const f32x4*)(SSQQ + (size_t)row * 4);
                const float rs = 1.0f / sqrtf(((p.x + p.y) + (p.z + p.w)) * (1.0f / 256.0f) + EPS);
#pragma unroll
                for (int bj = 0; bj < 2; ++bj) *(u32x4*)(QH + (size_t)row * 768 + u.pn * 256 + bj * 128 + wc * 32 + 8 * fq) = pk8(acc[ai][bj][m][0] * rs, acc[ai][bj][m][1] * rs);
            }
    }
};
struct EpiKVup {
    const float *SSQKV, *SSPE, *KPE, *kn, *ropeC; bf16_t *KH, *VH;
    DI void operator()(AccRef acc, const Unit& u, int wr, int wc, int fr, int fq) const {
        const int head = 2 * u.pn + (wc >> 1);
#pragma unroll
        for (int ai = 0; ai < 2; ++ai)
#pragma unroll
            for (int m = 0; m < 4; ++m) { EFENCE();
                const int row = EROW(u, ai, m); const f32x4 p = *(const f32x4*)(SSQKV + (size_t)row * 4);
                const float rs = 1.0f / sqrtf(((p.x + p.y) + (p.z + p.w)) * (1.0f / 128.0f) + EPS);
                f32x4 v[2][2];
#pragma unroll
                for (int bj = 0; bj < 2; ++bj)
#pragma unroll
                    for (int n = 0; n < 2; ++n) v[bj][n] = acc[ai][bj][m][n] * rs;
                float ss = sq4(v[0][0]) + sq4(v[0][1]) + sq4(v[1][0]) + sq4(v[1][1]); ss = sum4q(ss);
                if (wc & 1) {
#pragma unroll
                    for (int bj = 0; bj < 2; ++bj) *(u32x4*)(VH + (size_t)row * 512 + head * 64 + 32 * bj + 8 * fq) = pk8(v[bj][0], v[bj][1]);
                } else {
                    const float kr = 1.0f / sqrtf((ss + SSPE[row]) * (1.0f / 96.0f) + EPS);
                    bf16_t* kd = KH + (size_t)row * 768 + head * 96;
#pragma unroll
                    for (int bj = 0; bj < 2; ++bj) { const f32x4 g0 = *(const f32x4*)(kn + 32 * bj + 8 * fq), g1 = *(const f32x4*)(kn + 32 * bj + 8 * fq + 4);
                        *(u32x4*)(kd + 32 * bj + 8 * fq) = pk8(v[bj][0] * kr * g0, v[bj][1] * kr * g1); }
                    const f32x4 lo = *(const f32x4*)(KPE + (size_t)row * 32 + 4 * fq) * kr * *(const f32x4*)(kn + 64 + 4 * fq);
                    const f32x4 hi = *(const f32x4*)(KPE + (size_t)row * 32 + 16 + 4 * fq) * kr * *(const f32x4*)(kn + 80 + 4 * fq);
                    const f32x4 c = *(const f32x4*)(ropeC + (size_t)row * 32 + 4 * fq), s = *(const f32x4*)(ropeC + (size_t)row * 32 + 16 + 4 * fq);
                    const f32x4 olo = lo * c - hi * s, ohi = hi * c + lo * s;
                    u32x2 w0, w1; w0.x = cvtpk(olo.x, olo.y); w0.y = cvtpk(olo.z, olo.w); w1.x = cvtpk(ohi.x, ohi.y); w1.y = cvtpk(ohi.z, ohi.w);
                    *(u32x2*)(kd + 64 + 4 * fq) = w0; *(u32x2*)(kd + 80 + 4 * fq) = w1;
                }
            }
    }
};
struct EpiE {
    float* EB;
    DI void operator()(AccRef acc, const Unit& u, int wr, int wc, int fr, int fq) const {
#pragma unroll
        for (int ai = 0; ai < 2; ++ai)
#pragma unroll
            for (int m = 0; m < 4; ++m) { EFENCE(); const int row = EROW(u, ai, m);
#pragma unroll
                for (int bj = 0; bj < 2; ++bj) { float* d = EB + (size_t)row * 256 + bj * 128 + wc * 32 + 8 * fq; *(f32x4*)d = acc[ai][bj][m][0]; *(f32x4*)(d + 4) = acc[ai][bj][m][1]; } }
    }
};
DI float gelu_tanh(float y) { const float a = 0.7978845608028654f * (y + 0.044715f * y * y * y); return y * __builtin_amdgcn_rcpf(1.0f + __builtin_amdgcn_exp2f(-2.0f * LOG2E * a)); }
struct EpiY {
    bf16_t* Z;
    DI void operator()(AccRef acc, const Unit& u, int wr, int wc, int fr, int fq) const {
        const int g = u.pm >> 2, pni = u.pn & 3;
#pragma unroll
        for (int ai = 0; ai < 2; ++ai)
#pragma unroll
            for (int m = 0; m < 4; ++m) { EFENCE(); const int chunk = EROW(u, ai, m) - g * 1024;
#pragma unroll
                for (int bj = 0; bj < 2; ++bj) { const int n0 = pni * 256 + bj * 128 + wc * 32 + 8 * fq, tt = n0 >> 4, h0 = n0 & 15;
                    f32x4 a = acc[ai][bj][m][0], b = acc[ai][bj][m][1];
#pragma unroll
                    for (int k = 0; k < 4; ++k) { a[k] = gelu_tanh(a[k]); b[k] = gelu_tanh(b[k]); }
                    *(u32x4*)(Z + ((size_t)chunk * 64 + tt) * 256 + g * 16 + h0) = pk8(a, b); } }
    }
};
struct EpiGLU {
    const bf16_t* Z; const float* bglu; bf16_t* MG;
    DI void operator()(AccRef acc, const Unit& u, int wr, int wc, int fr, int fq) const {
#pragma unroll
        for (int ai = 0; ai < 2; ++ai)
#pragma unroll
            for (int m = 0; m < 4; ++m) { EFENCE(); const int row = EROW(u, ai, m);
#pragma unroll
                for (int bj = 0; bj < 2; ++bj) { const int col = bj * 128 + wc * 32 + 8 * fq;
                    const u32x4 zz = *(const u32x4*)(Z + (size_t)row * 256 + col);
                    const f32x4 b0 = *(const f32x4*)(bglu + col), b1 = *(const f32x4*)(bglu + col + 4);
                    f32x4 a = acc[ai][bj][m][0] + b0, b = acc[ai][bj][m][1] + b1;
                    const float z[8] = {bflo(zz.x), bfhi(zz.x), bflo(zz.y), bfhi(zz.y), bflo(zz.z), bfhi(zz.z), bflo(zz.w), bfhi(zz.w)};
#pragma unroll
                    for (int k = 0; k < 4; ++k) { a[k] = z[k] * __builtin_amdgcn_rcpf(1.0f + __builtin_amdgcn_exp2f(-LOG2E * a[k])); b[k] = z[4 + k] * __builtin_amdgcn_rcpf(1.0f + __builtin_amdgcn_exp2f(-LOG2E * b[k])); }
                    *(u32x4*)(MG + (size_t)row * 768 + 512 + col) = pk8(a, b); } }
    }
};

struct Args { const float* in[34]; float* out; unsigned char* ws; int ph_lo, ph_hi, rmask, pad; };

DI float wave_sum(float v) {
#pragma unroll
    for (int o = 1; o < 64; o <<= 1) v += shx(v, o);
    return v;
}
DI void xpose_item(const float* W, int ldw, int c0, const float* gain, bf16_t* WT, int K, int n0, int k0, LAS float* scr, int lane) {
#pragma unroll 16
    for (int i = 0; i < 32; ++i) { const int kk = 2 * i + (lane >> 5);
        float v = 0.f; if (W) { v = W[(size_t)(k0 + kk) * ldw + c0 + (lane & 31)]; if (gain) v *= gain[k0 + kk]; }
        scr[kk * 33 + (lane & 31)] = v; }
    const int c = lane & 7;
#pragma unroll
    for (int j = 0; j < 4; ++j) { const int n = (lane >> 3) + 8 * j; const LAS float* s = scr + (8 * c) * 33 + n;
        u32x4 o; o.x = cvtpk(s[0 * 33], s[1 * 33]); o.y = cvtpk(s[2 * 33], s[3 * 33]); o.z = cvtpk(s[4 * 33], s[5 * 33]); o.w = cvtpk(s[6 * 33], s[7 * 33]);
        *(u32x4*)(WT + (size_t)(n0 + n) * K + k0 + 8 * c) = o; }
}

DI void p0_weights(const Args& A, LAS unsigned char* lds, const int wv) {
    GET_TID(wv); const int lane = tid_ & 63, wave = wv, gw = blockIdx.x * 8 + wave, NGW = gridDim.x * 8;
    LAS float* scr = (LAS float*)(lds + wave * 16384);
    unsigned char* ws = A.ws;
    constexpr int I_GU = 176 * 16, I_DN = 32 * 44, I_FFN = I_GU + I_DN;
    constexpr int I_EIN = 56 * 16, I_EOUT = 32 * 12, I_EV = I_EIN + I_EOUT;
    constexpr int I_OIN = 24 * 16, I_QUP = 24 * 4, I_KVUP = 32 * 2, I_OOUT = 32 * 12, I_GLU = 8 * 4, I_OD = I_OIN + I_QUP + I_KVUP + I_OOUT + I_GLU;
    constexpr int NITEMS = 8 * I_FFN + 2 * I_EV + 2 * I_OD;
    for (int it = gw; it < NITEMS; it += NGW) {
        int r = it;
        if (r < 8 * I_FFN) {
            const int lf = r / I_FFN; r -= lf * I_FFN; const int l = lf >> 1, f = lf & 1;
            bf16_t* gu = (bf16_t*)(ws + WS_WFFN + lf * WFFN_STRIDE); bf16_t* dn = gu + (size_t)5632 * 1024;
            if (r < I_GU) { const int nb = r % 176, kb = r / 176, n0 = nb * 32, tile = n0 >> 8, w = n0 & 255, bj = w >> 7, j = w & 127;
                const float* W = INP((f ? 8 : 3) + bj) + (size_t)l * DM * FF;
                xpose_item(W, FF, tile * 128 + j, INP(f ? 7 : 2) + l * DM, gu, DM, n0, kb * 64, scr, lane);
            } else { r -= I_GU; const int nb = r % 32, kb = r / 32;
                xpose_item(INP(f ? 10 : 5) + (size_t)l * FF * DM, DM, nb * 32, nullptr, dn, FF, nb * 32, kb * 64, scr, lane); }
            continue;
        }
        r -= 8 * I_FFN;
        if (r < 2 * I_EV) {
            const int i = r / I_EV; r -= i * I_EV;
            bf16_t* win = (bf16_t*)(ws + WS_WEVEN + i * WEVEN_STRIDE); bf16_t* wout = win + (size_t)1792 * 1024;
            if (r < I_EIN) { const int nb = r % 56, kb = r / 56, n0 = nb * 32, tile = n0 >> 8, w = n0 & 255; int c0;
                if (tile < 6) { const int kind = tile >> 1, bj = w >> 7, wc = (w & 127) >> 5, head = 4 * (tile & 1) + wc; c0 = kind * 512 + head * 64 + 32 * bj; } else c0 = 1536 + w;
                xpose_item(INP(11) + (size_t)i * DM * 1792, 1792, c0, INP(6) + (2 * i) * DM, win, DM, n0, kb * 64, scr, lane);
            } else { r -= I_EIN; const int nb = r % 32, kb = r / 32;
                const bool zk = (ZMODE == 1 && kb * 64 < 512) || (ZMODE == 2 && kb * 64 >= 512);
                xpose_item(zk ? nullptr : INP(12) + (size_t)i * 768 * DM, DM, nb * 32, nullptr, wout, 768, nb * 32, kb * 64, scr, lane); }
            continue;
        }
        r -= 2 * I_EV;
        {
            const int i = r / I_OD; r -= i * I_OD;
            unsigned char* wb = ws + WS_WODD + i * WODD_STRIDE2;
            if (r < I_OIN) { const int nb = r % 24, kb = r / 24, n0 = nb * 32; const float* W = INP(16) + (size_t)i * DM * 672; int c0 = n0;
                if (n0 >= 416 && n0 < 512) W = nullptr; else if (n0 >= 512) c0 = 416 + (n0 - 512);
                xpose_item(W, 672, c0, INP(6) + (2 * i + 1) * DM, (bf16_t*)(wb + WO_IN), DM, n0, kb * 64, scr, lane); continue; }
            r -= I_OIN;
            if (r < I_QUP) { const int nb = r % 24, kb = r / 24;
                xpose_item(INP(19) + (size_t)i * 256 * 768, 768, nb * 32, INP(18) + i * 256, (bf16_t*)(wb + WO_Q), 256, nb * 32, kb * 64, scr, lane); continue; }
            r -= I_QUP;
            if (r < I_KVUP) { const int nb = r % 32, kb = r / 32, n0 = nb * 32, pn = n0 >> 8, w = n0 & 255, bj = w >> 7, wc = (w & 127) >> 5;
                const int head = 2 * pn + (wc >> 1), c0 = head * 128 + (wc & 1) * 64 + 32 * bj;
                xpose_item(INP(21) + (size_t)i * 128 * 1024, 1024, c0, INP(20) + i * 128, (bf16_t*)(wb + WO_KV), 128, n0, kb * 64, scr, lane); continue; }
            r -= I_KVUP;
            if (r < I_OOUT) { const int nb = r % 32, kb = r / 32;
                xpose_item(INP(17) + (size_t)i * 768 * DM, DM, nb * 32, nullptr, (bf16_t*)(wb + WO_OUT), 768, nb * 32, kb * 64, scr, lane); continue; }
            r -= I_OOUT;
            { const int nb = r % 8, kb = r / 8;
                xpose_item(INP(32) + (size_t)i * 256 * 256, 256, nb * 32, nullptr, (bf16_t*)(wb + WO_GLU), 256, nb * 32, kb * 64, scr, lane); }
        }
    }
}

DI void p0_rows(const Args& A, const int wv) {
    GET_TID(wv); const int lane = tid_ & 63, gw = blockIdx.x * 8 + wv, NGW = gridDim.x * 8;
    const float* x = INP(0); bf16_t* XB = (bf16_t*)(A.ws + WS_XB); float* SSQ = (float*)(A.ws + WS_SSQ);
    float* ropeA = (float*)(A.ws + WS_ROPEA); float* ropeC = (float*)(A.ws + WS_ROPEC); const int* pos = (const int*)INP(1);
    for (int row = gw; row < T; row += NGW) {
        const f32x4* xr = (const f32x4*)(x + (size_t)row * DM) + lane; float s = 0.f;
        unsigned long long* o8 = (unsigned long long*)(XB + (size_t)row * DM) + lane;
#pragma unroll
        for (int j = 0; j < 4; ++j) { const f32x4 v = xr[64 * j]; s += sq4(v); o8[64 * j] = (unsigned long long)cvtpk(v.x, v.y) | ((unsigned long long)cvtpk(v.z, v.w) << 32); }
        s = wave_sum(s);
        if (lane < 16) SSQ[(size_t)row * 16 + lane] = lane == 0 ? s : 0.f;
        const float p = (float)pos[row];
        if (lane < 8) { const float f = powf(500000.0f, -(float)(2 * lane) / 16.0f); const float a = p * f; ropeA[(size_t)row * 16 + lane] = cosf(a); ropeA[(size_t)row * 16 + 8 + lane] = sinf(a); }
        else if (lane >= 16 && lane < 32) { const int i = lane - 16; const float f = powf(500000.0f, -(float)(2 * i) / 32.0f); const float a = p * f; ropeC[(size_t)row * 32 + i] = cosf(a); ropeC[(size_t)row * 32 + 16 + i] = sinf(a); }
    }
}

DI void p0_fconst(const Args& A, const int wv) {
    GET_TID(wv); const int gtid = blockIdx.x * 512 + tid_, NT_ = gridDim.x * 512;
    unsigned char* fc = A.ws + WS_FCONST;
    bf16_t* d128c = (bf16_t*)(fc + FC_D128C); bf16_t* d128ns = (bf16_t*)(fc + FC_D128NS);
    bf16_t* d64c = (bf16_t*)(fc + FC_D64C); bf16_t* d64s = (bf16_t*)(fc + FC_D64S); bf16_t* d64ns = (bf16_t*)(fc + FC_D64NS);
    float* tw = (float*)(fc + FC_TW); bf16_t* PT = (bf16_t*)(fc + FC_PT); bf16_t* QT = (bf16_t*)(fc + FC_QT);
    const float TWO_PI = 6.283185307179586f;
    for (int e = gtid; e < 16384; e += NT_) { const int k = e >> 7, s = e & 127; const float a = TWO_PI * (float)((k * s) & 127) / 128.0f;
        d128c[e] = (bf16_t)(cvtpk(cosf(a), 0.f) & 0xffff); d128ns[e] = (bf16_t)(cvtpk(-sinf(a), 0.f) & 0xffff); }
    for (int e = gtid; e < 4096; e += NT_) { const int k = e >> 6, s = e & 63; const float a = TWO_PI * (float)((k * s) & 63) / 64.0f;
        d64c[e] = (bf16_t)(cvtpk(cosf(a), 0.f) & 0xffff); d64s[e] = (bf16_t)(cvtpk(sinf(a), 0.f) & 0xffff); d64ns[e] = (bf16_t)(cvtpk(-sinf(a), 0.f) & 0xffff); }
    for (int e = gtid; e < 8192; e += NT_) { const float a = TWO_PI * (float)e / 8192.0f; tw[2 * e] = cosf(a); tw[2 * e + 1] = sinf(a); }
    const float scale = 1.0f / sqrtf(8192.0f * 64.0f);
    for (int e = gtid; e < 2 * 4 * 64 * 64; e += NT_) {
        const int c = e & 63, d = (e >> 6) & 63, g = (e >> 12) & 3, ie = e >> 14;
        const float* M = INP(15) + ((size_t)(ie * 4 + g) * 64) * 64; float p = 0.f, q = 0.f;
        for (int l = 0; l < 64; ++l) { const float a = TWO_PI * (float)((l * c) & 63) / 64.0f; const float mv = M[l * 64 + d]; p += cosf(a) * mv; q += sinf(a) * mv; }
        PT[e] = (bf16_t)(cvtpk(p * scale, 0.f) & 0xffff); QT[e] = (bf16_t)(cvtpk(q * scale, 0.f) & 0xffff);
    }
}

DI void p0_s5tab(const Args& A, LAS unsigned char* lds, const int wv) {
    LAS f32x2* LPs = (LAS f32x2*)lds;
    LAS f32x2* BBs = (LAS f32x2*)(lds + 33280);
    LAS f32x2* Cs = (LAS f32x2*)(lds + 33280 + 8192);
    float* Ktab = (float*)(A.ws + WS_S5TAB + S5_KTAB); f32x2* LPg = (f32x2*)(A.ws + WS_S5TAB + S5_LP); f32x2* BBg = (f32x2*)(A.ws + WS_S5TAB + S5_BB);
    GET_TID(wv); const int tid = tid_;
    for (int task = blockIdx.x; task < 256; task += gridDim.x) {
        const int idg = task >> 2, qtr = task & 3;
        const float step = expf(INP(26)[idg]);
        const float* lre = INP(24) + idg * 64; const float* lim = INP(25) + idg * 64;
        for (int e = tid; e < 64 * 65; e += 512) { const int p = e / 65, tau = e % 65; const float ar = lre[p] * step * (float)tau, ai = lim[p] * step * (float)tau;
            const float mg = expf(ar); f32x2 v; v.x = mg * cosf(ai); v.y = mg * sinf(ai); LPs[e] = v; if (qtr == 0) LPg[(size_t)idg * 4160 + e] = v; }
        for (int e = tid; e < 1024; e += 512) { const int hh = e >> 6, p = e & 63; f32x2 c; c.x = INP(29)[(size_t)idg * 1024 + e]; c.y = INP(30)[(size_t)idg * 1024 + e]; Cs[hh * 64 + p] = c; }
        __syncthreads();
        for (int e = tid; e < 1024; e += 512) { const int p = e >> 4; const f32x2 lb = LPs[p * 65 + 1]; const float lr = lre[p], li = lim[p];
            const float nr = lb.x - 1.0f, ni = lb.y, den = lr * lr + li * li; const float qr = (nr * lr + ni * li) / den, qi = (ni * lr - nr * li) / den;
            const float br = INP(27)[(size_t)idg * 1024 + e], bi = INP(28)[(size_t)idg * 1024 + e];
            f32x2 v; v.x = qr * br - qi * bi; v.y = qr * bi + qi * br; BBs[e] = v; if (qtr == 0) BBg[(size_t)idg * 1024 + e] = v; }
        __syncthreads();
        for (int e = qtr * 4096 + tid; e < (qtr + 1) * 4096; e += 512) { const int tau = e >> 8, hp = (e >> 4) & 15, h = e & 15; float acc = 0.f;
            for (int p = 0; p < 64; ++p) { const f32x2 l = LPs[p * 65 + tau], b = BBs[p * 16 + h], c = Cs[hp * 64 + p];
                const float wr_ = l.x * b.x - l.y * b.y, wi_ = l.x * b.y + l.y * b.x; acc += c.x * wr_ - c.y * wi_; }
            Ktab[(size_t)idg * 16384 + e] = acc; }
        __syncthreads();
    }
}
DI void p0_s5mats(const Args& A, const int wv) {
    GET_TID(wv); const int gtid = blockIdx.x * 512 + tid_, NT_ = gridDim.x * 512;
    const float* Ktab = (const float*)(A.ws + WS_S5TAB + S5_KTAB); const f32x2* LPg = (const f32x2*)(A.ws + WS_S5TAB + S5_LP); const f32x2* BBg = (const f32x2*)(A.ws + WS_S5TAB + S5_BB);
    for (int e = gtid; e < 2 * 16 * 1024 * 160; e += NT_) {
        const int k8 = e % 160, n = (e / 160) & 1023, g = (e / (160 * 1024)) & 15, i = e / (160 * 1024 * 16);
        const int tt = n >> 4, hp = n & 15, k = k8 * 8; float v[8];
        if (k < 1024) { const int s = k >> 4, h0 = k & 15;
            if (s == tt) { const float* kf = Ktab + ((size_t)((i * 2 + 0) * 16 + g) * 64 + 0) * 256 + hp * 16 + h0; const float* kb = Ktab + ((size_t)((i * 2 + 1) * 16 + g) * 64 + 0) * 256 + hp * 16 + h0;
                for (int j = 0; j < 8; ++j) v[j] = kf[j] + kb[j] + ((h0 + j) == hp ? INP(31)[i * 256 + g * 16 + hp] : 0.f);
            } else { const int dir = s < tt ? 0 : 1, tau = s < tt ? tt - s : s - tt; const float* kt = Ktab + ((size_t)((i * 2 + dir) * 16 + g) * 64 + tau) * 256 + hp * 16 + h0;
                for (int j = 0; j < 8; ++j) v[j] = kt[j]; }
        } else { const int kk = k - 1024, dir = kk >> 7, p0 = (kk & 127) >> 1; const int idg = (i * 2 + dir) * 16 + g; const int pw = dir == 0 ? tt + 1 : 64 - tt;
            for (int j = 0; j < 4; ++j) { const int p = p0 + j; const f32x2 w = LPg[(size_t)idg * 4160 + p * 65 + pw];
                const float cr = INP(29)[(size_t)idg * 1024 + hp * 64 + p], ci = INP(30)[(size_t)idg * 1024 + hp * 64 + p];
                v[2 * j] = cr * w.x - ci * w.y; v[2 * j + 1] = -(cr * w.y + ci * w.x); } }
        bf16_t* dst = (bf16_t*)(A.ws + WS_WODD + i * WODD_STRIDE2 + WO_TMAT) + ((size_t)g * 1024 + n) * 1280 + k;
        u32x4 o; o.x = cvtpk(v[0], v[1]); o.y = cvtpk(v[2], v[3]); o.z = cvtpk(v[4], v[5]); o.w = cvtpk(v[6], v[7]); *(u32x4*)dst = o;
    }
    for (int e = gtid; e < 2 * 16 * 256 * 128; e += NT_) {
        const int k8 = e & 127, n = (e >> 7) & 255, g = (e >> 15) & 15, i = e >> 19;
        const int dir = n >> 7, p = (n & 127) >> 1, ri = n & 1, k = k8 * 8, s = k >> 4, h0 = k & 15; const int idg = (i * 2 + dir) * 16 + g;
        const f32x2 w = LPg[(size_t)idg * 4160 + p * 65 + (dir == 0 ? 63 - s : s)]; float v[8];
        for (int j = 0; j < 8; ++j) { const f32x2 b = BBg[(size_t)idg * 1024 + p * 16 + h0 + j]; v[j] = ri == 0 ? (w.x * b.x - w.y * b.y) : (w.x * b.y + w.y * b.x); }
        bf16_t* dst = (bf16_t*)(A.ws + WS_WODD + i * WODD_STRIDE2 + WO_EMAT) + ((size_t)g * 256 + n) * 1024 + k;
        u32x4 o; o.x = cvtpk(v[0], v[1]); o.y = cvtpk(v[2], v[3]); o.z = cvtpk(v[4], v[5]); o.w = cvtpk(v[6], v[7]); *(u32x4*)dst = o;
    }
}

DI void s5_scan(const Args& A, int i, const int wv) {
    GET_TID(wv); const int gtid = blockIdx.x * 512 + tid_, NT_ = gridDim.x * 512;
    const float* EB = (const float*)(A.ws + WS_MIX2 + M2_EB); bf16_t* UA = (bf16_t*)(A.ws + WS_MIX2 + M2_UA);
    for (int e = gtid; e < 8 * 16 * 128; e += NT_) {
        const int dp = e & 127, g = (e >> 7) & 15, b = e >> 11, dir = dp >> 6, p = dp & 63; const int idg = (i * 2 + dir) * 16 + g;
        const float step = expf(INP(26)[idg]); const float ar = INP(24)[idg * 64 + p] * step * 64.0f, ai = INP(25)[idg * 64 + p] * step * 64.0f;
        const float mg = expf(ar), lr = mg * cosf(ai), li = mg * sinf(ai);
        float hr = 0.f, hi = 0.f;
        for (int j0 = 0; j0 < 128; j0 += 8) {
            f32x2 ev[8];
#pragma unroll
            for (int u = 0; u < 8; ++u) { const int jj = j0 + u, j = dir == 0 ? jj : 127 - jj; ev[u] = *(const f32x2*)(EB + ((size_t)g * 1024 + b * 128 + j) * 256 + dir * 128 + 2 * p); }
#pragma unroll
            for (int u = 0; u < 8; ++u) { const int jj = j0 + u, j = dir == 0 ? jj : 127 - jj; const size_t row = (size_t)g * 1024 + b * 128 + j;
                *(unsigned*)(UA + row * 1280 + 1024 + dir * 128 + 2 * p) = cvtpk(hr, hi);
                const float nr = lr * hr - li * hi + ev[u].x, ni = lr * hi + li * hr + ev[u].y; hr = nr; hi = ni; }
        }
    }
}

DI void dilated_phase(const Args& A, LAS unsigned char* lds, int br, const int wv) {
    const int dl = br == 0 ? 1 : (br == 1 ? 4 : 16), L = SEQ / dl;
    const bf16_t* Q = (const bf16_t*)(A.ws + WS_HID + EV_Q); const bf16_t* Kp = (const bf16_t*)(A.ws + WS_HID + EV_K); const bf16_t* V = (const bf16_t*)(A.ws + WS_HID + EV_V);
    bf16_t* MG = (bf16_t*)(A.ws + WS_MERGED); float* LSE = (float*)(A.ws + WS_MIX2 + M2_LSE);
    GET_TID(wv);
    const int tid = tid_, lane = tid & 63, w = wv, r32 = lane & 31, h = lane >> 5, blk = (lane >> 4) & 1, q_ = (lane & 15) >> 2, p_ = lane & 3;
    const int wp = w >> 1, qh = w & 1;
    LAS unsigned char* vb = lds + wp * 27648;
    for (int bt = blockIdx.x; bt < 2048; bt += gridDim.x) {
        const int b = bt >> 8, x = bt & 255, hg = x & 1, y = x >> 1, r = y % dl, n = y / dl, head = hg * 4 + wp;
#pragma unroll
        for (int ps = 0; ps < 12; ++ps) { const int lp = qh * 64 + lane, row = ps * 16 + (lp >> 3), ch = lp & 7; int key = 64 * n - 64 + row; key = key < 0 ? 0 : (key >= L ? L - 1 : key);
            const size_t t = (size_t)b * SEQ + key * dl + r; const u32x4 v = *(const u32x4*)(V + t * 512 + head * 64 + ch * 8); *(LAS u32x4*)(vb + row * 144 + ch * 16) = v; }
        __syncthreads();
        const size_t tq = (size_t)b * SEQ + (64 * n + 32 * qh + r32) * dl + r;
        bf16x8 qf[4];
#pragma unroll
        for (int s = 0; s < 4; ++s) qf[s] = *(const bf16x8*)(Q + tq * 512 + head * 64 + 16 * s + 8 * h);
        const int kb0 = 64 * n - 64 + 32 * qh;
        f32x16 p[5];
        {
            bf16x8 kf[5][4];
#pragma unroll
            for (int kt = 0; kt < 5; ++kt) { int key = kb0 + 32 * kt + r32; key = key < 0 ? 0 : (key >= L ? L - 1 : key); const size_t tk = (size_t)b * SEQ + key * dl + r;
#pragma unroll
                for (int s = 0; s < 4; ++s) kf[kt][s] = *(const bf16x8*)(Kp + tk * 512 + head * 64 + 16 * s + 8 * h); }
#pragma unroll
            for (int kt = 0; kt < 5; ++kt) { f32x16 acc = zero16();
#pragma unroll
                for (int s = 0; s < 4; ++s) acc = MFMA32(kf[kt][s], qf[s], acc);
                p[kt] = acc; }
        }
        float lo_prev = 0.f; u32x2 od_prev[2][4];
        if (br > 0) { lo_prev = LSE[tq * 8 + head];
#pragma unroll
            for (int dt = 0; dt < 2; ++dt)
#pragma unroll
                for (int gq = 0; gq < 4; ++gq) od_prev[dt][gq] = *(const u32x2*)(MG + tq * 768 + head * 64 + 32 * dt + 8 * gq + 4 * h); }
        float mx = -1e30f;
#pragma unroll
        for (int kt = 0; kt < 5; ++kt)
#pragma unroll
            for (int rg = 0; rg < 16; ++rg) { const int jj = 32 * kt + crow(rg, h), key = kb0 + jj; const bool ok = (jj >= r32) && (jj <= r32 + 128) && (key >= 0) && (key < L);
                const float v = ok ? p[kt][rg] : -1e30f; p[kt][rg] = v; mx = fmaxf(mx, v); }
        mx = fmaxf(mx, shx(mx, 32));
        float l = 0.f;
#pragma unroll
        for (int kt = 0; kt < 5; ++kt)
#pragma unroll
            for (int rg = 0; rg < 16; ++rg) { const float v = __builtin_amdgcn_exp2f(p[kt][rg] - mx); p[kt][rg] = v; l += v; }
        l += shx(l, 32);
        f32x16 o[2]; o[0] = zero16(); o[1] = zero16();
#pragma unroll
        for (int kt = 0; kt < 5; ++kt)
#pragma unroll
            for (int s = 0; s < 2; ++s) { const bf16x8 pb = pack8(p[kt], s);
#pragma unroll
                for (int dt = 0; dt < 2; ++dt) { LAS const char* ad = (LAS const char*)vb + (32 * qh + 32 * kt + 16 * s + 4 * h + q_) * 144 + (32 * dt + 16 * blk) * 2 + 8 * p_;
                    const bf16x8 va = cat8(trread(ad), trread(ad + 8 * 144)); o[dt] = MFMA32(va, pb, o[dt]); } }
        const float inv = 1.0f / l; float lse = mx + __builtin_amdgcn_logf(l);
        float wn = inv, wo = 0.f;
        if (br > 0) { const float lo = lo_prev; const float mm = fmaxf(lo, lse); const float eo = __builtin_amdgcn_exp2f(lo - mm), en = __builtin_amdgcn_exp2f(lse - mm); const float den = eo + en;
            wo = eo / den; wn = en / den * inv; lse = mm + __builtin_amdgcn_logf(den); }
#pragma unroll
        for (int dt = 0; dt < 2; ++dt)
#pragma unroll
            for (int gq = 0; gq < 4; ++gq) { bf16_t* dst = MG + tq * 768 + head * 64 + 32 * dt + 8 * gq + 4 * h;
                float v0 = o[dt][4 * gq] * wn, v1 = o[dt][4 * gq + 1] * wn, v2 = o[dt][4 * gq + 2] * wn, v3 = o[dt][4 * gq + 3] * wn;
                if (br > 0) { const u32x2 od = od_prev[dt][gq]; v0 += wo * bflo(od.x); v1 += wo * bfhi(od.x); v2 += wo * bflo(od.y); v3 += wo * bfhi(od.y); }
                u32x2 ww; ww.x = cvtpk(v0, v1); ww.y = cvtpk(v2, v3); if (NOSTORE == 0) *(u32x2*)dst = ww; else if (ww.x == 0x12345678u) *(u32x2*)dst = ww; }
        if (h == 0) LSE[tq * 8 + head] = lse;
        __syncthreads();
    }
}

DI void fnet1_phase(const Args& A, LAS unsigned char* lds, const int wv) {
    const bf16_t* F = (const bf16_t*)(A.ws + WS_HID + EV_F); bf16_t* YP = (bf16_t*)(A.ws + WS_HID + EV_YP);
    const unsigned char* fc = A.ws + WS_FCONST; const bf16_t* d128c = (const bf16_t*)(fc + FC_D128C); const bf16_t* d128ns = (const bf16_t*)(fc + FC_D128NS); const f32x2* tw = (const f32x2*)(fc + FC_TW);
    GET_TID(wv);
    const int tid = tid_, lane = tid & 63, w = wv, r32 = lane & 31, h = lane >> 5, blk = (lane >> 4) & 1, q_ = (lane & 15) >> 2, p_ = lane & 3;
    LAS unsigned char* tb = lds + w * 16384;
    for (int task = blockIdx.x * 8 + w; task < 2048; task += gridDim.x * 8) {
        const int bg = task >> 6, s2 = task & 63, b = bg >> 2, g = bg & 3;
#pragma unroll
        for (int ps = 0; ps < 16; ++ps) { const int s1 = ps * 8 + (lane >> 3), ch = lane & 7; const size_t t = (size_t)b * SEQ + 64 * s1 + s2;
            const u32x4 v = *(const u32x4*)(F + t * 256 + g * 64 + ch * 8); *(LAS u32x4*)(tb + s1 * 128 + ch * 16) = v; }
        unsigned tro = (unsigned)(size_t)tb;
        asm volatile("s_waitcnt lgkmcnt(0)" : "+v"(tro) :: "memory");
        LAS const char* tbr = (LAS const char*)(size_t)tro;
        for (int mt = 0; mt < 4; ++mt) {
            f32x16 acc[2][2]; acc[0][0] = zero16p(); acc[0][1] = zero16p(); acc[1][0] = zero16p(); acc[1][1] = zero16p();
            bf16x8 acv[8], asv[8];
#pragma unroll
            for (int ks = 0; ks < 8; ++ks) { acv[ks] = *(const bf16x8*)(d128c + (32 * mt + r32) * 128 + 16 * ks + 8 * h); asv[ks] = *(const bf16x8*)(d128ns + (32 * mt + r32) * 128 + 16 * ks + 8 * h); }
#pragma unroll
            for (int ks = 0; ks < 8; ++ks) {
                const bf16x8 ac = acv[ks], as = asv[ks];
#pragma unroll
                for (int nt = 0; nt < 2; ++nt) { LAS const char* ad = tbr + (16 * ks + 8 * h + q_) * 128 + (32 * nt + 16 * blk) * 2 + 8 * p_;
                    const bf16x8 bf = cat8(trread(ad), trread(ad + 4 * 128));
                    acc[nt][0] = MFMA32(ac, bf, acc[nt][0]); acc[nt][1] = MFMA32(as, bf, acc[nt][1]); }
            }
#pragma unroll
            for (int rg = 0; rg < 16; ++rg) { const int k1 = 32 * mt + crow(rg, h); const float rev = (float)((k1 * s2) & 8191) * (1.0f / 8192.0f); f32x2 t2; t2.x = __builtin_amdgcn_cosf(rev); t2.y = __builtin_amdgcn_sinf(rev);
#pragma unroll
                for (int nt = 0; nt < 2; ++nt) { const float yr = acc[nt][0][rg], yi = acc[nt][1][rg]; const float zr = yr * t2.x + yi * t2.y, zi = yi * t2.x - yr * t2.y;
                    const unsigned pk = cvtpk(zr, zi); const size_t base = ((size_t)(bg * 128 + k1) * 2) * 4096 + s2 * 64 + 32 * nt + r32;
                    YP[base] = (bf16_t)(pk & 0xffff); YP[base + 4096] = (bf16_t)(pk >> 16); } }
        }
        asm volatile("s_waitcnt lgkmcnt(0)" ::: "memory");
    }
}
DI void fnet2_phase(const Args& A, LAS unsigned char* lds, int ie, const int wv) {
    const bf16_t* YP = (const bf16_t*)(A.ws + WS_HID + EV_YP); bf16_t* MG = (bf16_t*)(A.ws + WS_MERGED);
    const unsigned char* fc = A.ws + WS_FCONST; const bf16_t* d64c = (const bf16_t*)(fc + FC_D64C); const bf16_t* d64s = (const bf16_t*)(fc + FC_D64S); const bf16_t* d64ns = (const bf16_t*)(fc + FC_D64NS);
    const bf16_t* PT = (const bf16_t*)(fc + FC_PT) + (size_t)ie * 4 * 4096; const bf16_t* QT = (const bf16_t*)(fc + FC_QT) + (size_t)ie * 4 * 4096;
    GET_TID(wv);
    const int tid = tid_, lane = tid & 63, w = wv, r32 = lane & 31, h = lane >> 5, blk = (lane >> 4) & 1, q_ = (lane & 15) >> 2, p_ = lane & 3;
    LAS unsigned char* tb = lds + w * 16384;
    for (int task = blockIdx.x * 8 + w; task < 4096; task += gridDim.x * 8) {
        const int bg = task >> 7, k1 = task & 127, b = bg >> 2, g = bg & 3;
        const unsigned char* src = (const unsigned char*)(YP + ((size_t)(bg * 128 + k1) * 2) * 4096);
#pragma unroll
        for (int ps = 0; ps < 16; ++ps) { const u32x4 v = *(const u32x4*)(src + ps * 1024 + lane * 16); *(LAS u32x4*)(tb + ps * 1024 + lane * 16) = v; }
        unsigned tro = (unsigned)(size_t)tb;
        asm volatile("s_waitcnt lgkmcnt(0)" : "+v"(tro) :: "memory");
        LAS const char* tbr = (LAS const char*)(size_t)tro;
        for (int nt = 0; nt < 2; ++nt) {
            f32x16 xr[2], xi[2]; xr[0] = zero16p(); xr[1] = zero16p(); xi[0] = zero16p(); xi[1] = zero16p();
#pragma unroll
            for (int ks = 0; ks < 4; ++ks) {
                const int off = (32 * nt + r32) * 64 + 16 * ks + 8 * h;
                const bf16x8 bC = *(const bf16x8*)(d64c + off), bS = *(const bf16x8*)(d64s + off), bN = *(const bf16x8*)(d64ns + off);
#pragma unroll
                for (int ct = 0; ct < 2; ++ct) { LAS const char* ad = tbr + (16 * ks + 8 * h + q_) * 128 + (32 * ct + 16 * blk) * 2 + 8 * p_;
                    const bf16x8 aR = cat8(trread(ad), trread(ad + 4 * 128)); const bf16x8 aI = cat8(trread(ad + 8192), trread(ad + 8192 + 4 * 128));
                    xr[ct] = MFMA32(aR, bC, xr[ct]); xr[ct] = MFMA32(aI, bS, xr[ct]); xi[ct] = MFMA32(aI, bC, xi[ct]); xi[ct] = MFMA32(aR, bN, xi[ct]); }
            }
#pragma unroll
            for (int dt = 0; dt < 2; ++dt) {
                f32x16 oa = zero16p();
#pragma unroll
                for (int ct = 0; ct < 2; ++ct)
#pragma unroll
                    for (int s = 0; s < 2; ++s) { const bf16x8 pR = pack8(xr[ct], s), pI = pack8(xi[ct], s);
                        const int po = (g * 64 + 32 * dt + r32) * 64 + 32 * ct + 16 * s + 4 * h;
                        const bf16x8 aP = cat8(*(const s16x4*)(PT + po), *(const s16x4*)(PT + po + 8)), aQ = cat8(*(const s16x4*)(QT + po), *(const s16x4*)(QT + po + 8));
                        oa = MFMA32(aP, pR, oa); oa = MFMA32(aQ, pI, oa); }
                const size_t t = (size_t)b * SEQ + k1 + 128 * (32 * nt + r32);
#pragma unroll
                for (int gq = 0; gq < 4; ++gq) { u32x2 ww; ww.x = cvtpk(oa[4 * gq], oa[4 * gq + 1]); ww.y = cvtpk(oa[4 * gq + 2], oa[4 * gq + 3]);
                    *(u32x2*)(MG + t * 768 + 512 + g * 64 + 32 * dt + 8 * gq + 4 * h) = ww; }
            }
        }
        asm volatile("s_waitcnt lgkmcnt(0)" ::: "memory");
    }
}

DI void mla_phase(const Args& A, LAS unsigned char* lds, int i, const int wv) {
    const bf16_t* QH = (const bf16_t*)(A.ws + WS_HID + OD_QH); const bf16_t* KH = (const bf16_t*)(A.ws + WS_HID + OD_KH); const bf16_t* VH = (const bf16_t*)(A.ws + WS_HID + OD_VH);
    bf16_t* MG = (bf16_t*)(A.ws + WS_MERGED); const float* ropeC = (const float*)(A.ws + WS_ROPEC); const float* qn = INP(22) + i * 96;
    GET_TID(wv);
    const int tid = tid_, lane = tid & 63, w = wv, r32 = lane & 31, h = lane >> 5, blk = (lane >> 4) & 1, q_ = (lane & 15) >> 2, p_ = lane & 3;
    constexpr int KB = 64 * 208, VB = 64 * 144, BUF = KB + VB;
    for (int uid = blockIdx.x; uid < 2048; uid += gridDim.x) {
        const int bh = (uid >> 8) * 8 + (uid & 7), qb = (uid >> 3) & 31, b = bh >> 3, head = bh & 7;
        const size_t tq = (size_t)b * SEQ + qb * 256 + w * 32 + r32;
        bf16x8 qf[6];
        {
            float qv[6][8]; float ss = 0.f;
#pragma unroll
            for (int s = 0; s < 6; ++s) { const u32x4 raw = *(const u32x4*)(QH + tq * 768 + head * 96 + 16 * s + 8 * h);
                qv[s][0] = bflo(raw.x); qv[s][1] = bfhi(raw.x); qv[s][2] = bflo(raw.y); qv[s][3] = bfhi(raw.y); qv[s][4] = bflo(raw.z); qv[s][5] = bfhi(raw.z); qv[s][6] = bflo(raw.w); qv[s][7] = bfhi(raw.w);
#pragma unroll
                for (int j = 0; j < 8; ++j) ss += qv[s][j] * qv[s][j]; }
            ss += shx(ss, 32);
            const float rs = 1.0f / sqrtf(ss * (1.0f / 96.0f) + EPS);
#pragma unroll
            for (int s = 0; s < 6; ++s)
#pragma unroll
                for (int j = 0; j < 8; ++j) qv[s][j] *= rs * qn[16 * s + 8 * h + j];
#pragma unroll
            for (int j = 0; j < 8; ++j) { const float c = ropeC[tq * 32 + 8 * h + j], sn = ropeC[tq * 32 + 16 + 8 * h + j]; const float lo = qv[4][j], hi = qv[5][j];
                qv[4][j] = lo * c - hi * sn; qv[5][j] = hi * c + lo * sn; }
            const float sc = 0.10206207261596577f * LOG2E;
#pragma unroll
            for (int s = 0; s < 6; ++s) { u32x4 pk; pk.x = cvtpk(qv[s][0] * sc, qv[s][1] * sc); pk.y = cvtpk(qv[s][2] * sc, qv[s][3] * sc); pk.z = cvtpk(qv[s][4] * sc, qv[s][5] * sc); pk.w = cvtpk(qv[s][6] * sc, qv[s][7] * sc); qf[s] = __builtin_bit_cast(bf16x8, pk); }
        }
        const bf16_t* Kg = KH + ((size_t)b * SEQ) * 768 + head * 96; const bf16_t* Vg = VH + ((size_t)b * SEQ) * 512 + head * 64;
        u32x4 kq[3], vq[2];
#define MLA_LD(t) do { const size_t ro_ = (size_t)(t) * 128; \
        _Pragma("unroll") for (int c_ = 0; c_ < 3; ++c_) { const int id_ = tid + 512 * c_; kq[c_] = *(const u32x4*)(Kg + (ro_ + id_ / 12) * 768 + (id_ % 12) * 8); } \
        _Pragma("unroll") for (int c_ = 0; c_ < 2; ++c_) { const int id_ = tid + 512 * c_; vq[c_] = *(const u32x4*)(Vg + (ro_ + (id_ >> 3)) * 512 + (id_ & 7) * 8); } } while (0)
#define MLA_ST(buf) do { LAS unsigned char* d_ = lds + (buf) * TB; \
        _Pragma("unroll") for (int c_ = 0; c_ < 3; ++c_) { const int id_ = tid + 512 * c_; *(LAS u32x4*)(d_ + (id_ / 12) * 208 + (id_ % 12) * 16) = kq[c_]; } \
        _Pragma("unroll") for (int c_ = 0; c_ < 2; ++c_) { const int id_ = tid + 512 * c_; *(LAS u32x4*)(d_ + KB2 + (id_ >> 3) * 144 + (id_ & 7) * 16) = vq[c_]; } } while (0)
        constexpr int KB2 = 128 * 208, VB2 = 128 * 144, TB = KB2 + VB2;
        float mrow = 0.f, l = 0.f; f32x16 o[2]; o[0] = zero16(); o[1] = zero16(); f32x16 negm = zero16();
        MLA_LD(0); MLA_ST(0);
        __syncthreads();
        for (int j = 0; j < 64; ++j) {
            LAS const unsigned char* kb_ = lds + (j & 1) * TB; LAS const unsigned char* vbp = kb_ + KB2;
            if (j + 1 < 64) MLA_LD(j + 1);
            f32x16 p[4];
#pragma unroll
            for (int kt = 0; kt < 4; ++kt) p[kt] = negm;
#pragma unroll
            for (int s = 0; s < 6; ++s)
#pragma unroll
                for (int kt = 0; kt < 4; ++kt) { const bf16x8 ka = *(LAS const bf16x8*)(kb_ + (32 * kt + r32) * 208 + 32 * s + 16 * h); p[kt] = MFMA32(ka, qf[s], p[kt]); }
            float mx = fmaxf(fmaxf(p[0][0], p[1][0]), fmaxf(p[2][0], p[3][0]));
#pragma unroll
            for (int rg = 1; rg < 16; ++rg) mx = fmaxf(mx, fmaxf(fmaxf(p[0][rg], p[1][rg]), fmaxf(p[2][rg], p[3][rg])));
            mx = fmaxf(mx, shx(mx, 32));
            if (__any(mx > 8.0f)) {
                const float dl = fmaxf(mx, 0.f), alpha = __builtin_amdgcn_exp2f(-dl); mrow += dl; l *= alpha;
#pragma unroll
                for (int rg = 0; rg < 16; ++rg) { p[0][rg] -= dl; p[1][rg] -= dl; p[2][rg] -= dl; p[3][rg] -= dl; o[0][rg] *= alpha; o[1][rg] *= alpha; negm[rg] = -mrow; }
            }
            float ls = 0.f;
#pragma unroll
            for (int kt = 0; kt < 4; ++kt)
#pragma unroll
                for (int rg = 0; rg < 16; ++rg) { p[kt][rg] = __builtin_amdgcn_exp2f(p[kt][rg]); ls += p[kt][rg]; }
            l += ls;
#pragma unroll
            for (int kt = 0; kt < 4; ++kt)
#pragma unroll
                for (int s = 0; s < 2; ++s) { const bf16x8 pb = pack8(p[kt], s);
#pragma unroll
                    for (int dt = 0; dt < 2; ++dt) { LAS const char* ad = (LAS const char*)vbp + (32 * kt + 16 * s + 4 * h + q_) * 144 + (32 * dt + 16 * blk) * 2 + 8 * p_;
                        const bf16x8 va = cat8(trread(ad), trread(ad + 8 * 144)); o[dt] = MFMA32(va, pb, o[dt]); } }
            if (j + 1 < 64) MLA_ST((j + 1) & 1);
            __syncthreads();
        }
#undef MLA_LD
#undef MLA_ST
        l += shx(l, 32); const float inv = 1.0f / l;
#pragma unroll
        for (int dt = 0; dt < 2; ++dt)
#pragma unroll
            for (int gq = 0; gq < 4; ++gq) { u32x2 ww; ww.x = cvtpk(o[dt][4 * gq] * inv, o[dt][4 * gq + 1] * inv); ww.y = cvtpk(o[dt][4 * gq + 2] * inv, o[dt][4 * gq + 3] * inv);
                *(u32x2*)(MG + tq * 768 + head * 64 + 32 * dt + 8 * gq + 4 * h) = ww; }
    }
}

__global__ void __launch_bounds__(512, 2) fnet_k(Args A, int which) {
    extern __shared__ __attribute__((aligned(16))) unsigned char lds_raw2[];
    LAS unsigned char* lds = (LAS unsigned char*)lds_raw2;
    const int wv = __builtin_amdgcn_readfirstlane(threadIdx.x >> 6);
    if (which == 1) fnet1_phase(A, lds, wv); else fnet2_phase(A, lds, A.pad, wv);
}
__global__ void __launch_bounds__(512, 2) fwd_mega(Args A) {
    extern __shared__ __attribute__((aligned(16))) unsigned char lds_raw[];
    LAS unsigned char* lds = (LAS unsigned char*)lds_raw;
    const int wv = __builtin_amdgcn_readfirstlane(threadIdx.x >> 6);
    if (A.ph_hi - A.ph_lo > 1) cg::this_grid().sync();
    unsigned* gctr = (unsigned*)(A.ws + 256); unsigned epoch = 0;
    int ph = 0; const int ph_lo = A.ph_lo, ph_hi = A.ph_hi;
#define RUN (ph >= ph_lo && ph < ph_hi)
#define SEAM() do { if (ph >= ph_lo && ph + 1 < ph_hi) gbar(gctr, epoch, wv); ++ph; } while (0)
    unsigned gepoch = 0; const bool grp_ok = (gridDim.x & 7) == 0;
#define SEAMG() do { if (ph >= ph_lo && ph + 1 < ph_hi) { if (grp_ok) gbar_grp(gctr + 256, gepoch, wv); else gbar(gctr, epoch, wv); } ++ph; } while (0)
    unsigned char* ws = A.ws;
    bf16_t* XB = (bf16_t*)(ws + WS_XB); float* SSQ = (float*)(ws + WS_SSQ); bf16_t* HID = (bf16_t*)(ws + WS_HID); bf16_t* MG = (bf16_t*)(ws + WS_MERGED);

    if ((PM & 1) && (A.rmask & 1) && RUN) p0_s5tab(A, lds, wv);
    __syncthreads();
    if ((PM & 2) && (A.rmask & 2) && RUN) p0_weights(A, lds, wv);
    if ((PM & 4) && (A.rmask & 4) && RUN) p0_rows(A, wv);
    if ((PM & 8) && (A.rmask & 8) && RUN) p0_fconst(A, wv);
    SEAM();
    if ((PM & 16) && (A.rmask & 16) && RUN) p0_s5mats(A, wv);
    SEAM();

    for (int layer = 0; layer < NLAYERS; ++layer) {
        for (int f = 0; f < 2; ++f) {
            int bid = blockIdx.x, G = gridDim.x; asm volatile("" : "+s"(bid), "+s"(G));
            asm volatile("" : "+s"(ws));
            if (f == 1) {
                const int i = layer >> 1;
                if ((layer & 1) == 0) {
                    const bf16_t* win = (const bf16_t*)(ws + WS_WEVEN + i * WEVEN_STRIDE); const bf16_t* wout = win + (size_t)1792 * 1024;
                    { pg8::Gemm g{XB, win, DM, DM, DM}; pg8::StaticOrder S; S.init(T, 1792, G, bid);
                      EpiEvenIn E{SSQ, INP(13) + i * 64, INP(14) + i * 64, (const float*)(ws + WS_ROPEA), (bf16_t*)(ws + WS_HID + EV_Q), (bf16_t*)(ws + WS_HID + EV_K), (bf16_t*)(ws + WS_HID + EV_V), (bf16_t*)(ws + WS_HID + EV_F)};
                      if ((PM & 32) && (A.rmask & 32) && RUN) pg8::gemm_phase(lds, g, S, E, wv); }
                    SEAM();
                    if ((PM & 64) && (A.rmask & 64) && RUN) dilated_phase(A, lds, 0, wv);
                    if ((PM & 128) && (A.rmask & 128) && RUN) fnet1_phase(A, lds, wv);
                    SEAM();
                    if ((PM & 64) && (A.rmask & 64) && RUN) dilated_phase(A, lds, 1, wv);
                    if ((PM & 256) && (A.rmask & 256) && RUN) fnet2_phase(A, lds, i, wv);
                    SEAM();
                    if ((PM & 64) && (A.rmask & 64) && RUN) dilated_phase(A, lds, 2, wv);
                    SEAM();
                    { pg8::Gemm g{MG, wout, 768, 768, 768}; pg8::StaticOrder S; S.init(T, DM, G, bid);
                      EpiResid E{A.out, A.out, XB, SSQ, 1.0f}; if ((PM & 512) && (A.rmask & 512) && RUN) pg8::gemm_phase(lds, g, S, E, wv); }
                    SEAMG();
                } else {
                    unsigned char* wb = ws + WS_WODD + i * WODD_STRIDE2;
                    bf16_t* UA = (bf16_t*)(ws + WS_MIX2 + M2_UA); float* EB = (float*)(ws + WS_MIX2 + M2_EB); bf16_t* Z = (bf16_t*)(ws + WS_MIX2 + M2_Z);
                    { pg8::Gemm g{XB, (const bf16_t*)(wb + WO_IN), DM, DM, DM}; pg8::StaticOrder S; S.init(T, 768, G, bid);
                      EpiOddIn E{SSQ, (bf16_t*)(ws + WS_HID + OD_QLAT), (bf16_t*)(ws + WS_HID + OD_KVLAT), UA, (float*)(ws + WS_HID + OD_KPE), (float*)(ws + WS_HID + OD_SSQQ), (float*)(ws + WS_HID + OD_SSQKV), (float*)(ws + WS_HID + OD_SSPE)};
                      if ((PM & 1024) && (A.rmask & 1024) && RUN) pg8::gemm_phase(lds, g, S, E, wv); }
                    SEAM();
                    { pg8::Gemm g{UA, (const bf16_t*)(wb + WO_EMAT), 1280, 1024, 1024}; pg8::GroupOrder S{16, 4, 1, 4, 1, G, bid};
                      EpiE E{EB}; if ((PM & 2048) && (A.rmask & 2048) && RUN) pg8::gemm_phase(lds, g, S, E, wv); }
                    { pg8::Gemm g{(const bf16_t*)(ws + WS_HID + OD_QLAT), (const bf16_t*)(wb + WO_Q), 256, 256, 256}; pg8::StaticOrder S; S.init(T, 768, G, bid);
                      EpiQup E{(const float*)(ws + WS_HID + OD_SSQQ), (bf16_t*)(ws + WS_HID + OD_QH)}; if ((PM & 2048) && (A.rmask & 2048) && RUN) pg8::gemm_phase(lds, g, S, E, wv); }
                    { pg8::Gemm g{(const bf16_t*)(ws + WS_HID + OD_KVLAT), (const bf16_t*)(wb + WO_KV), 128, 128, 128}; pg8::StaticOrder S; S.init(T, 1024, G, bid);
                      EpiKVup E{(const float*)(ws + WS_HID + OD_SSQKV), (const float*)(ws + WS_HID + OD_SSPE), (const float*)(ws + WS_HID + OD_KPE), INP(23) + i * 96, (const float*)(ws + WS_ROPEC), (bf16_t*)(ws + WS_HID + OD_KH), (bf16_t*)(ws + WS_HID + OD_VH)};
                      if ((PM & 2048) && (A.rmask & 2048) && RUN) pg8::gemm_phase(lds, g, S, E, wv); }
                    SEAM();
                    if ((PM & 4096) && (A.rmask & 4096) && RUN) s5_scan(A, i, wv);
                    if ((PM & 8192) && (A.rmask & 8192) && RUN) mla_phase(A, lds, i, wv);
                    SEAM();
                    { pg8::Gemm g{UA, (const bf16_t*)(wb + WO_TMAT), 1280, 1280, 1280}; pg8::GroupOrder S{16, 4, 4, 4, 4, G, bid};
                      EpiY E{Z}; if ((PM & 16384) && (A.rmask & 16384) && RUN) pg8::gemm_phase(lds, g, S, E, wv); }
                    SEAM();
                    { pg8::Gemm g{Z, (const bf16_t*)(wb + WO_GLU), 256, 256, 256}; pg8::StaticOrder S; S.init(T, 256, G, bid);
                      EpiGLU E{Z, INP(33) + i * 256, MG}; if ((PM & 32768) && (A.rmask & 32768) && RUN) pg8::gemm_phase(lds, g, S, E, wv); }
                    SEAMG();
                    { pg8::Gemm g{MG, (const bf16_t*)(wb + WO_OUT), 768, 768, 768}; pg8::StaticOrder S; S.init(T, DM, G, bid);
                      EpiResid E{A.out, A.out, XB, SSQ, 1.0f}; if ((PM & 512) && (A.rmask & 512) && RUN) pg8::gemm_phase(lds, g, S, E, wv); }
                    SEAMG();
                }
            }
            const int lf = layer * 2 + f;
            const bf16_t* gu = (const bf16_t*)(ws + WS_WFFN + lf * WFFN_STRIDE); const bf16_t* dn = gu + (size_t)5632 * 1024;
            { pg8::Gemm g{XB, gu, DM, DM, DM}; pg8::StaticOrder S; S.init(T, 5632, G, bid);
              EpiSwiglu E{SSQ, HID}; if ((PM & 65536) && (A.rmask & 65536) && RUN) pg8::gemm_phase(lds, g, S, E, wv); }
            SEAMG();
            { pg8::Gemm g{HID, dn, FF, FF, FF}; pg8::StaticOrder S; S.init(T, DM, G, bid);
              EpiResid E{(layer == 0 && f == 0) ? INP(0) : A.out, A.out, XB, SSQ, 0.5f}; if ((PM & 512) && (A.rmask & 512) && RUN) pg8::gemm_phase(lds, g, S, E, wv); }
            if (f == 1 || (layer & 1)) SEAMG(); else SEAM();
        }
    }
}

extern "C" void kernel_launch(void* const* d_in, const int* in_sizes, int n_in, void* d_out, int out_size, void* d_ws, size_t ws_size, hipStream_t stream) {
    static int grid = 0;
    if (grid == 0) {
        int dev = 0, cus = 0, per_cu = 0;
        hipGetDevice(&dev); hipDeviceGetAttribute(&cus, hipDeviceAttributeMultiprocessorCount, dev);
        hipFuncSetAttribute((const void*)fwd_mega, hipFuncAttributeMaxDynamicSharedMemorySize, LDS_BYTES);
        hipOccupancyMaxActiveBlocksPerMultiprocessor(&per_cu, (const void*)fwd_mega, 512, LDS_BYTES);
        if (per_cu < 1) per_cu = 1;
        grid = cus * 1;
        if (n_in != 34 || ws_size < WS_END + 59 * MiB) fprintf(stderr, "kernel_launch: unexpected n_in %d / ws %zu\n", n_in, ws_size);
    }
    hipMemsetAsync(d_ws, 0, 4096, stream);
    Args a{};
    for (int i = 0; i < 34; ++i) a.in[i] = (const float*)d_in[i];
    a.out = (float*)d_out; a.ws = (unsigned char*)d_ws;
    constexpr int NPH = 40; a.rmask = RMASK;
#if MULTI == 1
    for (int ph = 0; ph < NPH; ++ph) { a.ph_lo = ph; a.ph_hi = ph + 1; hipLaunchKernelGGL(fwd_mega, dim3(grid), dim3(512), LDS_BYTES, stream, a); }
#elif MULTI == 2
    {
        static bool once = false; if (!once) { hipFuncSetAttribute((const void*)fnet_k, hipFuncAttributeMaxDynamicSharedMemorySize, LDS_BYTES); once = true; }
        const int seg[4] = {0, 7, 28, NPH}; a.rmask = RMASK & ~384;
        for (int sgi = 0; sgi < 3; ++sgi) {
            Args b = a; b.ph_lo = seg[sgi]; b.ph_hi = sgi < 2 ? seg[sgi + 1] - 2 : seg[sgi + 1];
            void* args[] = {&b};
            hipError_t e = hipLaunchCooperativeKernel((const void*)fwd_mega, dim3(grid), dim3(512), args, LDS_BYTES, stream);
            if (e != hipSuccess) fprintf(stderr, "cooperative launch failed: %s (grid %d)\n", hipGetErrorString(e), grid);
            if (sgi < 2) { Args c = a; c.pad = sgi; c.ph_lo = 0; c.ph_hi = 1;
                hipLaunchKernelGGL(fnet_k, dim3(grid), dim3(512), LDS_BYTES, stream, c, 1);
                hipLaunchKernelGGL(fnet_k, dim3(grid), dim3(512), LDS_BYTES, stream, c, 2); }
        }
    }
#else
    a.ph_lo = 0; a.ph_hi = NPH;
    void* args[] = {&a};
    hipError_t e = hipLaunchCooperativeKernel((const void*)fwd_mega, dim3(grid), dim3(512), args, LDS_BYTES, stream);
    if (e != hipSuccess) fprintf(stderr, "cooperative launch failed: %s (grid %d)\n", hipGetErrorString(e), grid);
#endif

}
```
